# Optimizing an MI355X kernel written in HIP

```python
import jax, jax.numpy as jnp
from jax import lax
import numpy as np

D_MODEL = 1024
BATCH = 16
SEQ = 2048
DEPTH = 1
DEC_BATCH = 32
DEC_SEQ = 16
PAST_LEN = 1024

CHUNK = 64
N_HEADS = 8
HEAD_DIM = 64
ATTN_WIDTH = N_HEADS * HEAD_DIM
POOL_WINDOWS = (2, 4, 8, 16)
N_POOL_GROUPS = len(POOL_WINDOWS)
POOL_WIDTH = D_MODEL // 2
POOL_GROUP = POOL_WIDTH // N_POOL_GROUPS
POOL_STATE = max(POOL_WINDOWS) - 1
D_FF = 2816
CONV_WIDTH = 3
Q_BLOCK = 128
EPS = 1e-6
IN_WIDTH = 3 * ATTN_WIDTH + POOL_WIDTH + 2 * D_MODEL

kernel_name = "stick_breaking_pool_hybrid_stream_step"


def rmsnorm(x, g):
    x32 = x.astype(jnp.float32)
    y = x32 * lax.rsqrt(jnp.mean(x32 * x32, axis=-1, keepdims=True) + EPS) * g.astype(jnp.float32)
    return y.astype(x.dtype)


def stick_breaking(q, k, v, q_pos, k_pos):
    z = jnp.einsum('bqhd,bkhd->bhqk', q.astype(jnp.float32), k.astype(jnp.float32)) * (HEAD_DIM ** -0.5)
    mask = (k_pos[None, :] < q_pos[:, None])[None, None]
    log_fail = jnp.where(mask, jax.nn.log_sigmoid(-z), 0.0)
    log_between = lax.cumsum(log_fail, axis=3, reverse=True) - log_fail
    a = jnp.where(mask, jnp.exp(jax.nn.log_sigmoid(z) + log_between), 0.0)
    return jnp.einsum('bhqk,bkhd->bqhd', a, v.astype(jnp.float32)).astype(v.dtype)


def stick_breaking_prompt(q, k, v):
    T = q.shape[1]
    pos = jnp.arange(T)
    outs = []
    for i in range(T // Q_BLOCK):
        lo, hi = i * Q_BLOCK, (i + 1) * Q_BLOCK
        outs.append(stick_breaking(q[:, lo:hi], k[:, :hi], v[:, :hi], pos[lo:hi], pos[:hi]))
    return jnp.concatenate(outs, axis=1)


def multi_scale_pool(u, left, pos0):
    T = u.shape[1]
    ext_raw = jnp.concatenate([left, u], axis=1)
    cs = jnp.cumsum(ext_raw.astype(jnp.float32), axis=1)
    cs = jnp.concatenate([jnp.zeros_like(cs[:, :1]), cs], axis=1)
    pos = pos0 + jnp.arange(T)
    end = POOL_STATE + 1
    groups = []
    for g, w in enumerate(POOL_WINDOWS):
        sl = slice(g * POOL_GROUP, (g + 1) * POOL_GROUP)
        win = cs[:, end:end + T, sl] - cs[:, end - w:end - w + T, sl]
        cnt = jnp.minimum(pos + 1, w).astype(jnp.float32)[None, :, None]
        groups.append(win / cnt)
    mean = jnp.concatenate(groups, axis=-1)
    return mean - u.astype(jnp.float32), ext_raw[:, -POOL_STATE:]


def causal_dwconv(h, left, w, b):
    T = h.shape[1]
    ext = jnp.concatenate([left, h], axis=1)
    out = b.astype(jnp.float32)
    for j in range(CONV_WIDTH):
        out = out + ext[:, j:j + T].astype(jnp.float32) * w[j].astype(jnp.float32)
    return out.astype(h.dtype), ext[:, -(CONV_WIDTH - 1):]


def trunk_layer(x, pos0, kv_past, pool_left, conv_left, norm_mix, w_in, w_a, w_b,
                pool_w, pool_scale, w_o, norm_ffn, w_up, conv_w, conv_b, w_down):
    B, T, _ = x.shape
    h = rmsnorm(x, norm_mix)
    proj = h @ w_in
    cuts = [ATTN_WIDTH, 2 * ATTN_WIDTH, 3 * ATTN_WIDTH,
            3 * ATTN_WIDTH + POOL_WIDTH, 3 * ATTN_WIDTH + POOL_WIDTH + D_MODEL]
    q, k, v, u, g_a, g_b = jnp.split(proj, cuts, axis=-1)
    q = q.reshape(B, T, N_HEADS, HEAD_DIM)
    k = k.reshape(B, T, N_HEADS, HEAD_DIM)
    v = v.reshape(B, T, N_HEADS, HEAD_DIM)

    if kv_past is None:
        attn = stick_breaking_prompt(q, k, v)
    else:
        ck, cv = kv_past
        past = ck.shape[1]
        k_all = jnp.concatenate([ck, k], axis=1)
        v_all = jnp.concatenate([cv, v], axis=1)
        attn = stick_breaking(q, k_all, v_all, past + jnp.arange(T), jnp.arange(past + T))
    branch_a = attn.reshape(B, T, ATTN_WIDTH) @ w_a

    pooled, pool_new = multi_scale_pool(u, pool_left, pos0)
    pmix = jnp.einsum('btgc,gcd->btgd', pooled.reshape(B, T, N_POOL_GROUPS, POOL_GROUP),
                      pool_w.astype(jnp.float32)).reshape(B, T, POOL_WIDTH)
    pmix = pmix * pool_scale.astype(jnp.float32)
    branch_b = pmix.astype(x.dtype) @ w_b

    merged = jax.nn.sigmoid(g_a) * branch_a + jax.nn.sigmoid(g_b) * branch_b
    x = x + merged @ w_o

    h2 = rmsnorm(x, norm_ffn)
    up = h2 @ w_up
    c, conv_new = causal_dwconv(up, conv_left, conv_w, conv_b)
    gate, val = jnp.split(c, [D_FF], axis=-1)
    x = x + (jax.nn.gelu(gate) * val) @ w_down
    return x, k, v, pool_new, conv_new


def setup_inputs(seed: int = 0) -> dict:
    key = jax.random.key(seed)
    ks = jax.random.split(key, 24)
    f32 = jnp.float32
    nrm = lambda k, shape, scale: jax.random.normal(k, shape, f32) * scale
    return {
        "x_prompt": nrm(ks[0], (BATCH, SEQ, D_MODEL), 1.0),
        "x_sample": nrm(ks[1], (DEC_BATCH, DEC_SEQ, D_MODEL), 1.0),
        "cache_k": nrm(ks[2], (DEPTH, DEC_BATCH, PAST_LEN, N_HEADS, HEAD_DIM), 1.0),
        "cache_v": nrm(ks[3], (DEPTH, DEC_BATCH, PAST_LEN, N_HEADS, HEAD_DIM), 1.0),
        "state_pool": nrm(ks[4], (DEPTH, DEC_BATCH, POOL_STATE, POOL_WIDTH), 1.0),
        "state_conv": nrm(ks[5], (DEPTH, DEC_BATCH, CONV_WIDTH - 1, 2 * D_FF), 1.0),
        "norm_mix": 1.0 + nrm(ks[6], (DEPTH, D_MODEL), 0.02),
        "w_in": nrm(ks[7], (DEPTH, D_MODEL, IN_WIDTH), D_MODEL ** -0.5),
        "w_a": nrm(ks[8], (DEPTH, ATTN_WIDTH, D_MODEL), ATTN_WIDTH ** -0.5),
        "w_b": nrm(ks[9], (DEPTH, POOL_WIDTH, D_MODEL), POOL_WIDTH ** -0.5),
        "pool_w": nrm(ks[10], (DEPTH, N_POOL_GROUPS, POOL_GROUP, POOL_GROUP), POOL_GROUP ** -0.5),
        "pool_scale": 1.0 + nrm(ks[11], (DEPTH, POOL_WIDTH), 0.02),
        "w_o": nrm(ks[12], (DEPTH, D_MODEL, D_MODEL), D_MODEL ** -0.5),
        "norm_ffn": 1.0 + nrm(ks[13], (DEPTH, D_MODEL), 0.02),
        "w_up": nrm(ks[14], (DEPTH, D_MODEL, 2 * D_FF), D_MODEL ** -0.5),
        "conv_w": nrm(ks[15], (DEPTH, CONV_WIDTH, 2 * D_FF), CONV_WIDTH ** -0.5),
        "conv_b": nrm(ks[16], (DEPTH, 2 * D_FF), 0.01),
        "w_down": nrm(ks[17], (DEPTH, D_FF, D_MODEL), D_FF ** -0.5),
        "norm_final": 1.0 + nrm(ks[18], (D_MODEL,), 0.02),
    }


def reference(x_prompt, x_sample, cache_k, cache_v, state_pool, state_conv,
              norm_mix, w_in, w_a, w_b, pool_w, pool_scale, w_o, norm_ffn,
              w_up, conv_w, conv_b, w_down, norm_final):
    xp, xs = x_prompt, x_sample
    kp, vp, pp, cp = [], [], [], []
    ksl, vsl, psl, csl = [], [], [], []
    for l in range(DEPTH):
        weights = (norm_mix[l], w_in[l], w_a[l], w_b[l], pool_w[l], pool_scale[l], w_o[l],
                   norm_ffn[l], w_up[l], conv_w[l], conv_b[l], w_down[l])
        pool_zero = jnp.zeros((xp.shape[0], POOL_STATE, POOL_WIDTH), xp.dtype)
        conv_zero = jnp.zeros((xp.shape[0], CONV_WIDTH - 1, 2 * D_FF), xp.dtype)
        xp, k_new, v_new, pool_new, conv_new = trunk_layer(
            xp, 0, None, pool_zero, conv_zero, *weights)
        kp.append(k_new); vp.append(v_new); pp.append(pool_new); cp.append(conv_new)
        xs, k_new, v_new, pool_new, conv_new = trunk_layer(
            xs, cache_k.shape[2], (cache_k[l], cache_v[l]), state_pool[l], state_conv[l], *weights)
        ksl.append(k_new); vsl.append(v_new); psl.append(pool_new); csl.append(conv_new)
    y_prompt = rmsnorm(xp, norm_final)
    y_sample = rmsnorm(xs, norm_final)
    return (y_prompt, y_sample,
            jnp.stack(kp), jnp.stack(vp), jnp.stack(pp), jnp.stack(cp),
            jnp.stack(ksl), jnp.stack(vsl), jnp.stack(psl), jnp.stack(csl))
```

```cpp
#include <hip/hip_runtime.h>
#include <cstdint>
#include <cstdio>

constexpr int D_MODEL = 1024, BATCH = 16, SEQ = 2048, DEC_BATCH = 32, DEC_SEQ = 16, PAST = 1024;
constexpr int NH = 8, HD = 64, AW = 512, PW = 512, PG = 128, PSTATE = 15, DFF = 2816, FF2 = 5632, INW = 4096;
constexpr float EPS = 1e-6f;

constexpr size_t O_YP = 0;
constexpr size_t O_YS = O_YP + (size_t)BATCH * SEQ * D_MODEL;
constexpr size_t O_KP = O_YS + (size_t)DEC_BATCH * DEC_SEQ * D_MODEL;
constexpr size_t O_VP = O_KP + (size_t)BATCH * SEQ * AW;
constexpr size_t O_PP = O_VP + (size_t)BATCH * SEQ * AW;
constexpr size_t O_CP = O_PP + (size_t)BATCH * PSTATE * PW;
constexpr size_t O_KS = O_CP + (size_t)BATCH * 2 * FF2;
constexpr size_t O_VS = O_KS + (size_t)DEC_BATCH * DEC_SEQ * AW;
constexpr size_t O_PS = O_VS + (size_t)DEC_BATCH * DEC_SEQ * AW;
constexpr size_t O_CS = O_PS + (size_t)DEC_BATCH * PSTATE * PW;
constexpr size_t O_END = O_CS + (size_t)DEC_BATCH * 2 * FF2;

template <int EPI>
__global__ void __launch_bounds__(256) gemm_f32(const float* __restrict__ A, int lda, const float* __restrict__ B, int ldb,
                                                float* C, int ldc, int M, int N, int K, const float* R, int ldr) {
    __shared__ float As[16][64 + 4];
    __shared__ float Bs[16][64 + 4];
    const int tid = threadIdx.x, tx = tid & 15, ty = tid >> 4;
    const int m0 = blockIdx.y * 64, n0 = blockIdx.x * 64;
    float acc[4][4];
#pragma unroll
    for (int i = 0; i < 4; ++i)
#pragma unroll
        for (int j = 0; j < 4; ++j) acc[i][j] = 0.f;
    for (int k0 = 0; k0 < K; k0 += 16) {
        {
            const int r = tid >> 2, c = (tid & 3) * 4;
            const float4 v = *(const float4*)(A + (size_t)(m0 + r) * lda + k0 + c);
            As[c + 0][r] = v.x; As[c + 1][r] = v.y; As[c + 2][r] = v.z; As[c + 3][r] = v.w;
        }
        {
            const int r = tid >> 4, c = (tid & 15) * 4;
            const float4 v = *(const float4*)(B + (size_t)(k0 + r) * ldb + n0 + c);
            Bs[r][c + 0] = v.x; Bs[r][c + 1] = v.y; Bs[r][c + 2] = v.z; Bs[r][c + 3] = v.w;
        }
        __syncthreads();
#pragma unroll
        for (int kk = 0; kk < 16; ++kk) {
            float a[4], b[4];
#pragma unroll
            for (int i = 0; i < 4; ++i) a[i] = As[kk][ty * 4 + i];
#pragma unroll
            for (int j = 0; j < 4; ++j) b[j] = Bs[kk][tx * 4 + j];
#pragma unroll
            for (int i = 0; i < 4; ++i)
#pragma unroll
                for (int j = 0; j < 4; ++j) acc[i][j] = fmaf(a[i], b[j], acc[i][j]);
        }
        __syncthreads();
    }
#pragma unroll
    for (int i = 0; i < 4; ++i) {
        const int r = m0 + ty * 4 + i;
#pragma unroll
        for (int j = 0; j < 4; ++j) {
            const int c = n0 + tx * 4 + j;
            float v = acc[i][j];
            if (EPI == 1) v += R[(size_t)r * ldr + c];
            C[(size_t)r * ldc + c] = v;
        }
    }
}

__global__ void __launch_bounds__(256) rmsnorm_k(const float* __restrict__ x, const float* __restrict__ g, float* out, int rows) {
    const int row = blockIdx.x * 4 + (threadIdx.x >> 6), lane = threadIdx.x & 63;
    if (row >= rows) return;
    const float* xr = x + (size_t)row * D_MODEL;
    float v[16]; float s = 0.f;
#pragma unroll
    for (int j = 0; j < 16; ++j) { v[j] = xr[lane + 64 * j]; s += v[j] * v[j]; }
#pragma unroll
    for (int o = 1; o < 64; o <<= 1) s += __shfl_xor(s, o);
    const float r = 1.0f / sqrtf(s * (1.0f / D_MODEL) + EPS);
#pragma unroll
    for (int j = 0; j < 16; ++j) out[(size_t)row * D_MODEL + lane + 64 * j] = v[j] * r * g[lane + 64 * j];
}

__device__ __forceinline__ float softplus_f(float z) { return fmaxf(z, 0.f) + log1pf(expf(-fabsf(z))); }

__global__ void __launch_bounds__(64) attn_naive(const float* __restrict__ proj, const float* __restrict__ ck, const float* __restrict__ cv,
                                                 int T, int past, float* out  ) {
    const int b = blockIdx.z, h = blockIdx.y, t = blockIdx.x * 64 + threadIdx.x;
    const bool valid = t < T;
    const int tt = valid ? t : T - 1;
    const float* qp = proj + ((size_t)b * T + tt) * INW + h * HD;
    float q[HD], o[HD];
#pragma unroll
    for (int d = 0; d < HD; ++d) { q[d] = qp[d] * 0.125f; o[d] = 0.f; }
    float carry = 0.f;
    const int tmax = min(T, blockIdx.x * 64 + 64);
    for (int s = tmax - 2; s >= 0; --s) {
        const float* kp = proj + ((size_t)b * T + s) * INW + AW + h * HD;
        const float* vp = kp + AW;
        float z = 0.f;
#pragma unroll
        for (int d = 0; d < HD; ++d) z = fmaf(q[d], kp[d], z);
        const bool m = s < t;
        const float sp = softplus_f(z);
        const float a = m ? expf(z - sp + carry) : 0.f;
        if (m) carry -= sp;
#pragma unroll
        for (int d = 0; d < HD; ++d) o[d] = fmaf(a, vp[d], o[d]);
    }
    for (int s = past - 1; s >= 0; --s) {
        const float* kp = ck + (((size_t)b * past + s) * NH + h) * HD;
        const float* vp = cv + (((size_t)b * past + s) * NH + h) * HD;
        float z = 0.f;
#pragma unroll
        for (int d = 0; d < HD; ++d) z = fmaf(q[d], kp[d], z);
        const float sp = softplus_f(z);
        const float a = expf(z - sp + carry);
        carry -= sp;
#pragma unroll
        for (int d = 0; d < HD; ++d) o[d] = fmaf(a, vp[d], o[d]);
    }
    if (valid) {
        float* op = out + ((size_t)b * T + t) * AW + h * HD;
#pragma unroll
        for (int d = 0; d < HD; ++d) op[d] = o[d];
    }
}

__global__ void __launch_bounds__(256) pool_k(const float* __restrict__ proj, const float* __restrict__ left, int T, int pos0, float* pooled  ,
                                               float* pool_new  ) {
    const size_t idx = (size_t)blockIdx.x * 256 + threadIdx.x;
    const int c = (int)(idx % PW); const size_t bt = idx / PW; const int t = (int)(bt % T), b = (int)(bt / T);
    const int g = c / PG; const int w = 2 << g;
    float s = 0.f;
    for (int j = 0; j < w; ++j) {
        const int tj = t - j;
        float v;
        if (tj >= 0) v = proj[((size_t)b * T + tj) * INW + 1536 + c];
        else v = left ? left[((size_t)b * PSTATE + (PSTATE + tj)) * PW + c] : 0.f;
        s += v;
    }
    const int pos = pos0 + t; const float cnt = (float)min(pos + 1, w);
    pooled[idx] = s / cnt - proj[((size_t)b * T + t) * INW + 1536 + c];
    const int e = t - (T - PSTATE);
    if (e >= 0) pool_new[((size_t)b * PSTATE + e) * PW + c] = proj[((size_t)b * T + t) * INW + 1536 + c];
}

__global__ void __launch_bounds__(256) scale_cols_k(float* x, const float* __restrict__ s, int ncols, size_t n) {
    const size_t idx = (size_t)blockIdx.x * 256 + threadIdx.x; if (idx >= n) return;
    x[idx] *= s[idx % ncols];
}

__device__ __forceinline__ float sigmoid_f(float x) { return 1.f / (1.f + expf(-x)); }

__global__ void __launch_bounds__(256) merge_k(const float* __restrict__ proj, const float* __restrict__ A, const float* __restrict__ B, float* out, size_t n) {
    const size_t idx = (size_t)blockIdx.x * 256 + threadIdx.x; if (idx >= n) return;
    const size_t r = idx / D_MODEL; const int c = (int)(idx % D_MODEL);
    const float ga = proj[r * INW + 2048 + c], gb = proj[r * INW + 3072 + c];
    out[idx] = sigmoid_f(ga) * A[idx] + sigmoid_f(gb) * B[idx];
}

__device__ __forceinline__ float gelu_tanh(float x) {
    const float k = 0.7978845608028654f;
    return 0.5f * x * (1.f + tanhf(k * (x + 0.044715f * x * x * x)));
}

__global__ void __launch_bounds__(256) convact_k(const float* __restrict__ up, const float* __restrict__ left, const float* __restrict__ cw, const float* __restrict__ cb,
                                                  int T, float* act, float* conv_new) {
    const size_t idx = (size_t)blockIdx.x * 256 + threadIdx.x;
    const int c = (int)(idx % DFF); const size_t bt = idx / DFF; const int t = (int)(bt % T), b = (int)(bt / T);
    float r[2];
#pragma unroll
    for (int hh = 0; hh < 2; ++hh) {
        const int cc = c + hh * DFF;
        float o = cb[cc];
#pragma unroll
        for (int j = 0; j < 3; ++j) {
            const int tj = t - 2 + j;
            float v;
            if (tj >= 0) v = up[((size_t)b * T + tj) * FF2 + cc];
            else v = left ? left[((size_t)b * 2 + (2 + tj)) * FF2 + cc] : 0.f;
            o += v * cw[j * FF2 + cc];
        }
        r[hh] = o;
        if (t >= T - 2) conv_new[((size_t)b * 2 + (t - (T - 2))) * FF2 + cc] = up[((size_t)b * T + t) * FF2 + cc];
    }
    act[idx] = gelu_tanh(r[0]) * r[1];
}

__global__ void __launch_bounds__(256) copy_cols_k(const float* __restrict__ src, int lds_, int col0, float* dst, int ncols, size_t n) {
    const size_t idx = (size_t)blockIdx.x * 256 + threadIdx.x; if (idx >= n) return;
    const size_t r = idx / ncols; const int c = (int)(idx % ncols);
    dst[idx] = src[r * lds_ + col0 + c];
}

template <int EPI>
static void gemm(hipStream_t st, const float* A, int lda, const float* B, int ldb, float* C, int ldc, int M, int N, int K, const float* R = nullptr, int ldr = 0) {
    dim3 grid(N / 64, M / 64);
    hipLaunchKernelGGL(gemm_f32<EPI>, grid, dim3(256), 0, st, A, lda, B, ldb, C, ldc, M, N, K, R, ldr);
}

struct W {
    const float *norm_mix, *w_in, *w_a, *w_b, *pool_w, *pool_scale, *w_o, *norm_ffn, *w_up, *conv_w, *conv_b, *w_down, *norm_final;
};

static void run_chunk(hipStream_t st, const W& w, const float* x, int nb, int T, int pos0, const float* ck, const float* cv, int past,
                      const float* pool_left, const float* conv_left, float* ws,
                      float* y, float* k_out, float* v_out, float* pool_out, float* conv_out) {
    const int rows = nb * T;
    float* H = ws;
    float* PROJ = H + (size_t)rows * D_MODEL;
    float* ATT = PROJ + (size_t)rows * FF2;
    float* POOLED = ATT + (size_t)rows * AW;
    float* PMIX = POOLED + (size_t)rows * PW;
    float* BA = PMIX + (size_t)rows * PW;
    float* BB = BA + (size_t)rows * D_MODEL;
    float* MERGED = BB + (size_t)rows * D_MODEL;
    float* X1 = MERGED + (size_t)rows * D_MODEL;
    float* ACT = X1 + (size_t)rows * D_MODEL;
    float* UP = PROJ;

    hipLaunchKernelGGL(rmsnorm_k, dim3((rows + 3) / 4), dim3(256), 0, st, x, w.norm_mix, H, rows);
    gemm<0>(st, H, D_MODEL, w.w_in, INW, PROJ, INW, rows, INW, D_MODEL);
    {
        const size_t n = (size_t)rows * AW;
        hipLaunchKernelGGL(copy_cols_k, dim3((unsigned)((n + 255) / 256)), dim3(256), 0, st, PROJ, INW, 512, k_out, AW, n);
        hipLaunchKernelGGL(copy_cols_k, dim3((unsigned)((n + 255) / 256)), dim3(256), 0, st, PROJ, INW, 1024, v_out, AW, n);
    }
    hipLaunchKernelGGL(attn_naive, dim3((T + 63) / 64, NH, nb), dim3(64), 0, st, PROJ, ck, cv, T, past, ATT);
    gemm<0>(st, ATT, AW, w.w_a, D_MODEL, BA, D_MODEL, rows, D_MODEL, AW);
    {
        const size_t n = (size_t)rows * PW;
        hipLaunchKernelGGL(pool_k, dim3((unsigned)(n / 256)), dim3(256), 0, st, PROJ, pool_left, T, pos0, POOLED, pool_out);
        for (int g = 0; g < 4; ++g) gemm<0>(st, POOLED + g * PG, PW, w.pool_w + (size_t)g * PG * PG, PG, PMIX + g * PG, PW, rows, PG, PG);
        hipLaunchKernelGGL(scale_cols_k, dim3((unsigned)(n / 256)), dim3(256), 0, st, PMIX, w.pool_scale, PW, n);
    }
    gemm<0>(st, PMIX, PW, w.w_b, D_MODEL, BB, D_MODEL, rows, D_MODEL, PW);
    {
        const size_t n = (size_t)rows * D_MODEL;
        hipLaunchKernelGGL(merge_k, dim3((unsigned)(n / 256)), dim3(256), 0, st, PROJ, BA, BB, MERGED, n);
    }
    gemm<1>(st, MERGED, D_MODEL, w.w_o, D_MODEL, X1, D_MODEL, rows, D_MODEL, D_MODEL, x, D_MODEL);
    hipLaunchKernelGGL(rmsnorm_k, dim3((rows + 3) / 4), dim3(256), 0, st, X1, w.norm_ffn, H, rows);
    gemm<0>(st, H, D_MODEL, w.w_up, FF2, UP, FF2, rows, FF2, D_MODEL);
    {
        const size_t n = (size_t)rows * DFF;
        hipLaunchKernelGGL(convact_k, dim3((unsigned)(n / 256)), dim3(256), 0, st, UP, conv_left, w.conv_w, w.conv_b, T, ACT, conv_out);
    }
    gemm<1>(st, ACT, DFF, w.w_down, D_MODEL, MERGED  , D_MODEL, rows, D_MODEL, DFF, X1, D_MODEL);
    hipLaunchKernelGGL(rmsnorm_k, dim3((rows + 3) / 4), dim3(256), 0, st, MERGED, w.norm_final, y, rows);
}

extern "C" void kernel_launch(void* const* d_in, const int* in_sizes, int n_in, void* d_out, int out_size, void* d_ws, size_t ws_size, hipStream_t stream) {
    const float* x_prompt = (const float*)d_in[0];
    const float* x_sample = (const float*)d_in[1];
    const float* cache_k = (const float*)d_in[2];
    const float* cache_v = (const float*)d_in[3];
    const float* state_pool = (const float*)d_in[4];
    const float* state_conv = (const float*)d_in[5];
    W w;
    w.norm_mix = (const float*)d_in[6]; w.w_in = (const float*)d_in[7]; w.w_a = (const float*)d_in[8]; w.w_b = (const float*)d_in[9];
    w.pool_w = (const float*)d_in[10]; w.pool_scale = (const float*)d_in[11]; w.w_o = (const float*)d_in[12]; w.norm_ffn = (const float*)d_in[13];
    w.w_up = (const float*)d_in[14]; w.conv_w = (const float*)d_in[15]; w.conv_b = (const float*)d_in[16]; w.w_down = (const float*)d_in[17];
    w.norm_final = (const float*)d_in[18];
    float* out = (float*)d_out; float* ws = (float*)d_ws;
    if ((size_t)out_size != O_END) fprintf(stderr, "kernel_launch: unexpected out_size %d vs %zu\n", out_size, (size_t)O_END);
    constexpr int CB = 4;
    for (int c = 0; c < BATCH / CB; ++c) {
        const size_t r0 = (size_t)c * CB * SEQ;
        run_chunk(stream, w, x_prompt + r0 * D_MODEL, CB, SEQ, 0, nullptr, nullptr, 0, nullptr, nullptr, ws,
                  out + O_YP + r0 * D_MODEL, out + O_KP + r0 * AW, out + O_VP + r0 * AW,
                  out + O_PP + (size_t)c * CB * PSTATE * PW, out + O_CP + (size_t)c * CB * 2 * FF2);
    }
    run_chunk(stream, w, x_sample, DEC_BATCH, DEC_SEQ, PAST, cache_k, cache_v, PAST, state_pool, state_conv, ws,
              out + O_YS, out + O_KS, out + O_VS, out + O_PS, out + O_CS);
}
```

```cpp
#include <hip/hip_runtime.h>
#include <hip/hip_bf16.h>
#include <cstdio>
#include <cstdint>

constexpr int D_MODEL = 1024, BATCH = 16, SEQ = 2048, DEC_BATCH = 32, DEC_SEQ = 16, PAST = 1024;
constexpr int NH = 8, HD = 64, AW = 512, PW = 512, PG = 128, PSTATE = 15, DFF = 2816, FF2 = 5632, INW = 4096;
constexpr int MP = BATCH * SEQ, MS = DEC_BATCH * DEC_SEQ, M = MP + MS;
constexpr float EPS = 1e-6f;
constexpr float C2 = 0.125f * 1.4426950408889634f;

constexpr size_t O_YP = 0;
constexpr size_t O_YS = O_YP + (size_t)MP * D_MODEL;
constexpr size_t O_KP = O_YS + (size_t)MS * D_MODEL;
constexpr size_t O_VP = O_KP + (size_t)MP * AW;
constexpr size_t O_PP = O_VP + (size_t)MP * AW;
constexpr size_t O_CP = O_PP + (size_t)BATCH * PSTATE * PW;
constexpr size_t O_KS = O_CP + (size_t)BATCH * 2 * FF2;
constexpr size_t O_VS = O_KS + (size_t)MS * AW;
constexpr size_t O_PS = O_VS + (size_t)MS * AW;
constexpr size_t O_CS = O_PS + (size_t)DEC_BATCH * PSTATE * PW;
constexpr size_t O_END = O_CS + (size_t)DEC_BATCH * 2 * FF2;

namespace pg8 {
#define PG8_LAS __attribute__((address_space(3)))
typedef unsigned short bf16_t;
typedef short bf16x8 __attribute__((ext_vector_type(8)));
typedef float f32x4 __attribute__((ext_vector_type(4)));
typedef unsigned u32x4 __attribute__((ext_vector_type(4)));
constexpr int BM = 256, BK = 64, HALF = 128, HTB = HALF * BK * 2, STAGE_BYTES = 8 * HTB, NXCD = 8, WGM = 8;

__host__ __device__ __forceinline__ int lds_byte(int r, int c) { const int st = (r >> 4) * 2 + (c >> 5), rr = r & 15, cc = c & 31, ob = rr * 64 + cc * 2; return st * 1024 + (ob ^ (((ob >> 9) & 1) << 5)); }
__host__ __device__ __forceinline__ void stage_rc(int b, int& R, int& C) { const int st = b / 1024, sb = b % 1024, swz = sb ^ (((sb >> 9) & 1) << 5); R = (st >> 1) * 16 + swz / 64; C = (st & 1) * 32 + (swz % 64) / 2; }
__host__ __device__ __forceinline__ int perm32(int rho) { const int n = rho >> 4, i = rho & 15; return 8 * (i >> 2) + 4 * n + (i & 3); }

struct Unit { int pm, pn; };
struct Gemm { const bf16_t* A; const bf16_t* Bt; int M, N, K, lda; };

struct StaticOrder {
    int nM, nN, nwg, G, c;
    __host__ __device__ void init(int M_, int N_, int G_, int c_) { nM = M_ / BM; nN = N_ / BM; nwg = nM * nN; G = G_; c = c_; }
    __host__ __device__ bool next(int i, Unit& u) const {
        const long L = (long)i * G + c; if (L >= nwg) return false;
        int wgid = (int)L; { const int q = nwg / NXCD, r = nwg % NXCD, xcd = wgid % NXCD, off = wgid / NXCD; wgid = (xcd < r ? xcd * (q + 1) : r * (q + 1) + (xcd - r) * q) + off; }
        const int nig = WGM * nN, gid = wgid / nig, fm = gid * WGM, gsz = (nM - fm) < WGM ? (nM - fm) : WGM;
        u.pm = fm + ((wgid % nig) % gsz); u.pn = (wgid % nig) / gsz; return true;
    }
};

__device__ __forceinline__ unsigned cvt_pk_bf16(float lo, float hi) { unsigned r; asm volatile("v_cvt_pk_bf16_f32 %0, %1, %2" : "=v"(r) : "v"(lo), "v"(hi)); return r; }
__device__ __forceinline__ float bf_lo(unsigned u) { return __uint_as_float(u << 16); }
__device__ __forceinline__ float bf_hi(unsigned u) { return __uint_as_float(u & 0xffff0000u); }

template <class Epi, class Sched, bool ALIGN_EPI>
__device__ __forceinline__ void gemm_phase(PG8_LAS unsigned char* lds, const Gemm g, const Sched& S, const Epi& E) {
    const int tid = threadIdx.x, wid = __builtin_amdgcn_readfirstlane(tid >> 6), lane = tid & 63, wr = wid >> 2, wc = wid & 3, fr = lane & 15, fq = lane >> 4;
    const int K = g.K, nt = K / BK, lda = g.lda;
    unsigned voffA[2], voffB[2];
#pragma unroll
    for (int i = 0; i < 2; ++i) { int R, C; stage_rc(tid * 16 + i * 8192, R, C); const int Rb = Epi::PERM ? ((R & ~31) + perm32(R & 31)) : R;
        voffA[i] = (unsigned)(R * lda + C) * 2u; voffB[i] = (unsigned)(Rb * K + C) * 2u; }
    const size_t kstep = (size_t)(BK * 2);
    const size_t hstepA = (size_t)HALF * lda * 2, hstepB = (size_t)HALF * K * 2;
    const size_t tstepA = 2 * hstepA, tstepB = 2 * hstepB;
    const unsigned ldsw = (unsigned)wid * 1024u;
    const int aoff = lds_byte(wr * 64 + fr, fq * 8), boff = lds_byte(wc * 32 + fr, fq * 8);
#define PG8_SA(b, h) (((b) * 2 + (h)) * HTB)
#define PG8_SB(b, h) ((4 + (b) * 2 + (h)) * HTB)
#define PG8_STAGE(bufoff, gbase, voff) do { _Pragma("unroll") for (int _i = 0; _i < 2; ++_i) \
        __builtin_amdgcn_global_load_lds((const unsigned*)((const char*)(gbase) + (voff)[_i]), (PG8_LAS unsigned*)(lds + (bufoff) + ldsw + _i * 8192), 16, 0, 0); } while (0)
#define PG8_LDA(dst, b, h) do { _Pragma("unroll") for (int m = 0; m < 4; ++m) _Pragma("unroll") for (int k = 0; k < 2; ++k) dst[m][k] = *(const PG8_LAS bf16x8*)(lds + PG8_SA(b, h) + aoff + m * 2048 + k * 1024); } while (0)
#define PG8_LDB(dst, b, h) do { _Pragma("unroll") for (int n = 0; n < 2; ++n) _Pragma("unroll") for (int k = 0; k < 2; ++k) dst[n][k] = *(const PG8_LAS bf16x8*)(lds + PG8_SB(b, h) + boff + n * 2048 + k * 1024); } while (0)
#define PG8_MMA(ai, bj, At, Bt) do { __builtin_amdgcn_s_setprio(1); _Pragma("unroll") for (int m = 0; m < 4; ++m) _Pragma("unroll") for (int n = 0; n < 2; ++n) _Pragma("unroll") for (int k = 0; k < 2; ++k) \
        acc[ai][bj][m][n] = __builtin_amdgcn_mfma_f32_16x16x32_bf16(Bt[n][k], At[m][k], acc[ai][bj][m][n], 0, 0, 0); __builtin_amdgcn_s_setprio(0); } while (0)
#define PG8_WAIT_V(n) asm volatile("s_waitcnt vmcnt(" #n ")" ::: "memory")
#define PG8_WAIT_L(n) asm volatile("s_waitcnt lgkmcnt(" #n ")" ::: "memory")
#define PG8_BAR __builtin_amdgcn_s_barrier()
#define PG8_SCHED __builtin_amdgcn_sched_barrier(0)
    Unit cur, nxt; int ui = 0;
    if (!S.next(0, cur)) return;
    f32x4 acc[2][2][4][2];
#pragma unroll
    for (int a = 0; a < 2; ++a)
#pragma unroll
        for (int b = 0; b < 2; ++b)
#pragma unroll
            for (int m = 0; m < 4; ++m)
#pragma unroll
                for (int n = 0; n < 2; ++n) acc[a][b][m][n] = (f32x4){0.f, 0.f, 0.f, 0.f};
    bf16x8 At[4][2], B0[2][2], B1[2][2];
    const char* cA = (const char*)g.A + (size_t)cur.pm * tstepA; const char* cB = (const char*)g.Bt + (size_t)cur.pn * tstepB;
    PG8_STAGE(PG8_SB(0, 0), cB, voffB); PG8_STAGE(PG8_SB(0, 1), cB + hstepB, voffB); PG8_STAGE(PG8_SA(0, 0), cA, voffA); PG8_STAGE(PG8_SA(0, 1), cA + hstepA, voffA);
    if (wr == 1) PG8_BAR;
    PG8_WAIT_V(2); PG8_BAR;
    PG8_STAGE(PG8_SB(1, 0), cB + kstep, voffB); PG8_STAGE(PG8_SA(1, 0), cA + kstep, voffA); PG8_STAGE(PG8_SB(1, 1), cB + hstepB + kstep, voffB);
    PG8_WAIT_V(6); PG8_BAR;
    for (;;) {
        const bool has_next = S.next(ui + 1, nxt);
        const char* nA = has_next ? (const char*)g.A + (size_t)nxt.pm * tstepA : cA; const char* nB = has_next ? (const char*)g.Bt + (size_t)nxt.pn * tstepB : cB;
        for (int t = 0; t < nt; t += 2) {
            const bool last = (t == nt - 2);
            const char* a1 = cA + (size_t)(t + 1) * kstep;
            const char* a2 = last ? nA : cA + (size_t)(t + 2) * kstep; const char* b2 = last ? nB : cB + (size_t)(t + 2) * kstep;
            const char* a3 = a2 + kstep; const char* b3 = b2 + kstep;
            PG8_LDB(B0, 0, 0); PG8_LDB(B1, 0, 1); PG8_SCHED; PG8_LDA(At, 0, 0); PG8_STAGE(PG8_SA(1, 1), a1 + hstepA, voffA);
            PG8_WAIT_V(8); PG8_WAIT_L(0); PG8_BAR; PG8_MMA(0, 0, At, B0); PG8_MMA(0, 1, At, B1); PG8_BAR; PG8_SCHED;
            PG8_LDA(At, 0, 1); PG8_STAGE(PG8_SB(0, 0), b2, voffB); PG8_STAGE(PG8_SB(0, 1), b2 + hstepB, voffB); PG8_STAGE(PG8_SA(0, 0), a2, voffA);
            PG8_WAIT_V(8); PG8_WAIT_L(0); PG8_BAR; PG8_MMA(1, 0, At, B0); PG8_MMA(1, 1, At, B1); PG8_BAR; PG8_SCHED;
            PG8_LDB(B0, 1, 0); PG8_LDB(B1, 1, 1); PG8_SCHED; PG8_LDA(At, 1, 0); PG8_STAGE(PG8_SA(0, 1), a2 + hstepA, voffA);
            PG8_WAIT_V(8); PG8_WAIT_L(0); PG8_BAR; PG8_MMA(0, 0, At, B0); PG8_MMA(0, 1, At, B1); PG8_BAR; PG8_SCHED;
            PG8_LDA(At, 1, 1); PG8_STAGE(PG8_SB(1, 0), b3, voffB); PG8_STAGE(PG8_SB(1, 1), b3 + hstepB, voffB); PG8_STAGE(PG8_SA(1, 0), a3, voffA);
            PG8_WAIT_V(8); PG8_WAIT_L(0); PG8_BAR; PG8_MMA(1, 0, At, B0); PG8_MMA(1, 1, At, B1); PG8_BAR; PG8_SCHED;
        }
        if constexpr (ALIGN_EPI) { if (wr == 0) PG8_BAR; }
        E(acc, cur, wr, wc, fr, fq);
        if (!has_next) break;
#pragma unroll
        for (int a = 0; a < 2; ++a)
#pragma unroll
            for (int b = 0; b < 2; ++b)
#pragma unroll
                for (int m = 0; m < 4; ++m)
#pragma unroll
                    for (int n = 0; n < 2; ++n) acc[a][b][m][n] = (f32x4){0.f, 0.f, 0.f, 0.f};
        cur = nxt; cA = nA; cB = nB; ++ui;
        if constexpr (ALIGN_EPI) { if (wr == 1) PG8_BAR; }
    }
    PG8_WAIT_V(0);
    if constexpr (!ALIGN_EPI) { if (wr == 0) PG8_BAR; }
    PG8_BAR;
#undef PG8_SA
#undef PG8_SB
#undef PG8_STAGE
#undef PG8_LDA
#undef PG8_LDB
#undef PG8_MMA
#undef PG8_WAIT_V
#undef PG8_WAIT_L
#undef PG8_BAR
#undef PG8_SCHED
}

__device__ __forceinline__ float sigmoid_fast(float x) { return __builtin_amdgcn_rcpf(1.0f + __builtin_amdgcn_exp2f(-1.4426950408889634f * x)); }

struct EpiIn {
    static constexpr bool PERM = true;
    const float* rstd; bf16_t* QB; bf16_t* KB; bf16_t* VB; float* UB; bf16_t* SG; float* out;
    __device__ __forceinline__ void operator()(const f32x4 (&acc)[2][2][4][2], const Unit& u, int wr, int wc, int fr, int fq) const {
        const int pn = u.pn, pm = u.pm;
        bf16_t* db = nullptr; float* df = nullptr; int ldb = 0, ldf = 0, cbase = 0; float mult = 1.f; bool sig = false;
        if (pn < 2) { db = QB; ldb = AW; cbase = 0; mult = C2; }
        else if (pn < 4) { db = KB; ldb = AW; cbase = 512; df = (pm < MP / 256) ? out + O_KP : out + O_KS - (size_t)MP * AW; ldf = AW; }
        else if (pn < 6) { db = VB; ldb = AW; cbase = 1024; df = (pm < MP / 256) ? out + O_VP : out + O_VS - (size_t)MP * AW; ldf = AW; }
        else if (pn < 8) { df = UB; ldf = PW; cbase = 1536; }
        else { db = SG; ldb = 2048; cbase = 2048; sig = true; }
        const int row0 = pm * BM + wr * 64 + fr;
        const int col0 = pn * BM + wc * 32 + 8 * fq - cbase;
#pragma unroll
        for (int ai = 0; ai < 2; ++ai)
#pragma unroll
            for (int m = 0; m < 4; ++m) {
                const int row = row0 + ai * HALF + m * 16;
                const float rs = rstd[row] * mult;
#pragma unroll
                for (int bj = 0; bj < 2; ++bj) {
                    f32x4 v0 = acc[ai][bj][m][0] * rs, v1 = acc[ai][bj][m][1] * rs;
                    const int col = col0 + bj * HALF;
                    if (sig) {
#pragma unroll
                        for (int e = 0; e < 4; ++e) { v0[e] = sigmoid_fast(v0[e]); v1[e] = sigmoid_fast(v1[e]); }
                    }
                    if (db) { u32x4 w; w.x = cvt_pk_bf16(v0[0], v0[1]); w.y = cvt_pk_bf16(v0[2], v0[3]); w.z = cvt_pk_bf16(v1[0], v1[1]); w.w = cvt_pk_bf16(v1[2], v1[3]);
                        *(u32x4*)(db + (size_t)row * ldb + col) = w; }
                    if (df) { float* p = df + (size_t)row * ldf + col; *(f32x4*)p = v0; *(f32x4*)(p + 4) = v1; }
                }
            }
    }
};

template <bool ACCUM> struct EpiGate {
    static constexpr bool PERM = true;
    bf16_t* MG; const bf16_t* SG; int goff;
    __device__ __forceinline__ void operator()(const f32x4 (&acc)[2][2][4][2], const Unit& u, int wr, int wc, int fr, int fq) const {
        const int row0 = u.pm * BM + wr * 64 + fr, col0 = u.pn * BM + wc * 32 + 8 * fq;
#pragma unroll
        for (int ai = 0; ai < 2; ++ai)
#pragma unroll
            for (int m = 0; m < 4; ++m) {
                const int row = row0 + ai * HALF + m * 16;
#pragma unroll
                for (int bj = 0; bj < 2; ++bj) {
                    const int col = col0 + bj * HALF;
                    const u32x4 gv = *(const u32x4*)(SG + (size_t)row * 2048 + goff + col);
                    f32x4 v0 = acc[ai][bj][m][0], v1 = acc[ai][bj][m][1];
                    v0[0] *= bf_lo(gv.x); v0[1] *= bf_hi(gv.x); v0[2] *= bf_lo(gv.y); v0[3] *= bf_hi(gv.y);
                    v1[0] *= bf_lo(gv.z); v1[1] *= bf_hi(gv.z); v1[2] *= bf_lo(gv.w); v1[3] *= bf_hi(gv.w);
                    bf16_t* dp = MG + (size_t)row * D_MODEL + col;
                    if (ACCUM) { const u32x4 ov = *(const u32x4*)dp;
                        v0[0] += bf_lo(ov.x); v0[1] += bf_hi(ov.x); v0[2] += bf_lo(ov.y); v0[3] += bf_hi(ov.y);
                        v1[0] += bf_lo(ov.z); v1[1] += bf_hi(ov.z); v1[2] += bf_lo(ov.w); v1[3] += bf_hi(ov.w); }
                    u32x4 w; w.x = cvt_pk_bf16(v0[0], v0[1]); w.y = cvt_pk_bf16(v0[2], v0[3]); w.z = cvt_pk_bf16(v1[0], v1[1]); w.w = cvt_pk_bf16(v1[2], v1[3]);
                    *(u32x4*)dp = w;
                }
            }
    }
};

struct EpiRes1 {
    static constexpr bool PERM = true;
    const float* xp; const float* xs; float* X1; bf16_t* X1B; float* SSQ;
    __device__ __forceinline__ void operator()(const f32x4 (&acc)[2][2][4][2], const Unit& u, int wr, int wc, int fr, int fq) const {
        const int row0 = u.pm * BM + wr * 64 + fr, col0 = u.pn * BM + wc * 32 + 8 * fq;
        const float* xsrc = (u.pm < MP / 256) ? xp : xs - (size_t)MP * D_MODEL;
#pragma unroll
        for (int ai = 0; ai < 2; ++ai)
#pragma unroll
            for (int m = 0; m < 4; ++m) {
                const int row = row0 + ai * HALF + m * 16; float s = 0.f;
#pragma unroll
                for (int bj = 0; bj < 2; ++bj) {
                    const size_t off = (size_t)row * D_MODEL + col0 + bj * HALF;
                    const f32x4 x0 = *(const f32x4*)(xsrc + off), x1 = *(const f32x4*)(xsrc + off + 4);
                    const f32x4 v0 = acc[ai][bj][m][0] + x0, v1 = acc[ai][bj][m][1] + x1;
                    s += (v0[0] * v0[0] + v0[1] * v0[1]) + (v0[2] * v0[2] + v0[3] * v0[3]) + (v1[0] * v1[0] + v1[1] * v1[1]) + (v1[2] * v1[2] + v1[3] * v1[3]);
                    *(f32x4*)(X1 + off) = v0; *(f32x4*)(X1 + off + 4) = v1;
                    u32x4 w; w.x = cvt_pk_bf16(v0[0], v0[1]); w.y = cvt_pk_bf16(v0[2], v0[3]); w.z = cvt_pk_bf16(v1[0], v1[1]); w.w = cvt_pk_bf16(v1[2], v1[3]);
                    *(u32x4*)(X1B + off) = w;
                }
                s += __shfl_xor(s, 16); s += __shfl_xor(s, 32);
                if (fq == 0) SSQ[(size_t)row * 16 + u.pn * 4 + wc] = s;
            }
    }
};

struct EpiUp {
    static constexpr bool PERM = true;
    const float* SSQ; bf16_t* UP; bf16_t* HALO; float* out;
    __device__ __forceinline__ void operator()(const f32x4 (&acc)[2][2][4][2], const Unit& u, int wr, int wc, int fr, int fq) const {
        const int row0 = u.pm * BM + wr * 64 + fr, col0 = u.pn * BM + wc * 32 + 8 * fq;
        const bool prompt = u.pm < MP / 256;
#pragma unroll
        for (int ai = 0; ai < 2; ++ai)
#pragma unroll
            for (int m = 0; m < 4; ++m) {
                const int row = row0 + ai * HALF + m * 16;
                const f32x4* sp = (const f32x4*)(SSQ + (size_t)row * 16);
                const f32x4 s0 = sp[0], s1 = sp[1], s2 = sp[2], s3 = sp[3];
                const float ss = ((s0[0] + s0[1]) + (s0[2] + s0[3])) + ((s1[0] + s1[1]) + (s1[2] + s1[3])) + ((s2[0] + s2[1]) + (s2[2] + s2[3])) + ((s3[0] + s3[1]) + (s3[2] + s3[3]));
                const float rs = __builtin_amdgcn_rsqf(ss * (1.0f / D_MODEL) + EPS);
                const bool halo = (row & 31) >= 30;
                float* cdst = nullptr;
                if (prompt) { if ((row & (SEQ - 1)) >= SEQ - 2) cdst = out + O_CP + ((size_t)(row >> 11) * 2 + ((row & (SEQ - 1)) - (SEQ - 2))) * FF2; }
                else { if ((row & 15) >= 14) cdst = out + O_CS + ((size_t)((row - MP) >> 4) * 2 + ((row & 15) - 14)) * FF2; }
#pragma unroll
                for (int bj = 0; bj < 2; ++bj) {
                    const int col = col0 + bj * HALF;
                    const f32x4 v0 = acc[ai][bj][m][0] * rs, v1 = acc[ai][bj][m][1] * rs;
                    u32x4 w; w.x = cvt_pk_bf16(v0[0], v0[1]); w.y = cvt_pk_bf16(v0[2], v0[3]); w.z = cvt_pk_bf16(v1[0], v1[1]); w.w = cvt_pk_bf16(v1[2], v1[3]);
                    *(u32x4*)(UP + (size_t)row * FF2 + col) = w;
                    if (halo) *(u32x4*)(HALO + ((size_t)(row >> 5) * 2 + ((row & 31) - 30)) * FF2 + col) = w;
                    if (cdst) { *(f32x4*)(cdst + col) = v0; *(f32x4*)(cdst + col + 4) = v1; }
                }
            }
    }
};

struct EpiRes2 {
    static constexpr bool PERM = true;
    float* X;
    __device__ __forceinline__ void operator()(const f32x4 (&acc)[2][2][4][2], const Unit& u, int wr, int wc, int fr, int fq) const {
        const int row0 = u.pm * BM + wr * 64 + fr, col0 = u.pn * BM + wc * 32 + 8 * fq;
#pragma unroll
        for (int ai = 0; ai < 2; ++ai)
#pragma unroll
            for (int m = 0; m < 4; ++m) {
                const int row = row0 + ai * HALF + m * 16;
#pragma unroll
                for (int bj = 0; bj < 2; ++bj) {
                    float* p = X + (size_t)row * D_MODEL + col0 + bj * HALF;
                    const f32x4 x0 = *(const f32x4*)p, x1 = *(const f32x4*)(p + 4);
                    *(f32x4*)p = acc[ai][bj][m][0] + x0; *(f32x4*)(p + 4) = acc[ai][bj][m][1] + x1;
                }
            }
    }
};
}

#define GAS __attribute__((address_space(1)))
#define LAS __attribute__((address_space(3)))
typedef unsigned short bf16;
typedef unsigned v4u __attribute__((ext_vector_type(4)));
typedef unsigned v2u __attribute__((ext_vector_type(2)));
typedef float f32x4 __attribute__((ext_vector_type(4)));
typedef float f32x16 __attribute__((ext_vector_type(16)));
typedef short bf16x8 __attribute__((ext_vector_type(8)));
typedef short v4i16_t __attribute__((ext_vector_type(4)));
typedef GAS unsigned gu32;
#define RLX_AGENT __ATOMIC_RELAXED, __HIP_MEMORY_SCOPE_AGENT
#define LDS_WAIT() asm volatile("s_waitcnt lgkmcnt(0)" ::: "memory")
#define VM_WAIT() asm volatile("s_waitcnt vmcnt(0)" ::: "memory")
__device__ __forceinline__ unsigned f2bf(float f) { unsigned u = __builtin_bit_cast(unsigned, f); return (u + 0x7fffu + ((u >> 16) & 1u)) >> 16; }
__device__ __forceinline__ unsigned pk2(float lo, float hi) { return f2bf(lo) | (f2bf(hi) << 16); }
__device__ __forceinline__ float bflo(unsigned u) { return __uint_as_float(u << 16); }
__device__ __forceinline__ float bfhi(unsigned u) { return __uint_as_float(u & 0xffff0000u); }

#define XB_TMO      128
#define XB_XCNT(j)  (256  + 64 * (j))
#define XB_XSUB(j)  (1280 + 64 * (j))
#define XB_XGEN(j)  (2304 + 64 * (j))
#define XB_TOP      3328
#define XB_TOPGEN   3392
#define XCD_BAR_WORDS 3456
#define XB_SPIN_CAP (1u << 18)

__device__ __forceinline__ unsigned xb_ld(unsigned* p)              { return __hip_atomic_load(p, __ATOMIC_RELAXED, __HIP_MEMORY_SCOPE_AGENT); }
__device__ __forceinline__ unsigned xb_add(unsigned* p, unsigned v) { return __hip_atomic_fetch_add(p, v, __ATOMIC_RELAXED, __HIP_MEMORY_SCOPE_AGENT); }
__device__ __forceinline__ unsigned xb_xcc_id() { return (unsigned)__builtin_amdgcn_s_getreg((3 << 11) | 20) & 0xFu; }
#define XB_SPIN(cond, bar) do { unsigned _sp = 0; while (cond) { __builtin_amdgcn_s_sleep(1); \
    if ((++_sp & 255u) == 0u) { if (xb_ld(&(bar)[XB_TMO])) break; if (_sp > XB_SPIN_CAP) { atomicAdd(&(bar)[XB_TMO], 1u); break; } } } } while (0)

struct XcdBarrier { unsigned* bar; unsigned x; volatile LAS unsigned* st; };

__device__ __forceinline__ XcdBarrier xcd_barrier_post(unsigned* bar, volatile LAS unsigned* st) {
    XcdBarrier b; b.bar = bar; b.x = xb_xcc_id(); b.st = st;
    if (threadIdx.x == 0) (void)xb_add(&bar[XB_XCNT(b.x)], 1u);
    return b;
}
__device__ __forceinline__ void xcd_barrier_complete(unsigned* bar, unsigned x, unsigned& nloc, unsigned& nx) {
    const unsigned G = gridDim.x * gridDim.y * gridDim.z;
    unsigned sum, cnt, mine, sp = 0u;
    for (;;) {
        sum = 0u; cnt = 0u; mine = 0u;
#pragma unroll
        for (unsigned j = 0; j < 16; ++j) { const unsigned c = xb_ld(&bar[XB_XCNT(j)]); sum += c; cnt += (c > 0u) ? 1u : 0u; mine = (j == x) ? c : mine; }
        if (sum == G) break;
        __builtin_amdgcn_s_sleep(1);
        if ((++sp & 255u) == 0u) { if (xb_ld(&bar[XB_TMO])) break; if (sp > XB_SPIN_CAP) { atomicAdd(&bar[XB_TMO], 1u); break; } }
    }
    nloc = mine > 0u ? mine : 1u; nx = cnt > 0u ? cnt : 1u;
}
__device__ __forceinline__ void xcd_barrier(const XcdBarrier& b) {
    asm volatile("s_waitcnt vmcnt(0)" ::: "memory");
    __syncthreads();
    if (threadIdx.x == 0) {
        unsigned* bar = b.bar;
        __builtin_amdgcn_s_waitcnt(0);
        unsigned nloc = b.st[0], nx = b.st[1];
        if (nloc == 0u) { xcd_barrier_complete(bar, b.x, nloc, nx); b.st[0] = nloc; b.st[1] = nx; }
        const unsigned old = xb_add(&bar[XB_XSUB(b.x)], 1u);
        const unsigned gen = old / nloc;
        if (old + 1u == (gen + 1u) * nloc) {
            __builtin_amdgcn_fence(__ATOMIC_RELEASE, "agent");
            asm volatile("s_waitcnt vmcnt(0)" ::: "memory");
            const unsigned og = xb_add(&bar[XB_TOP], 1u);
            const unsigned tg = og / nx;
            if (og + 1u == (tg + 1u) * nx) xb_add(&bar[XB_TOPGEN], 1u);
            else XB_SPIN(xb_ld(&bar[XB_TOPGEN]) == tg, bar);
            __builtin_amdgcn_fence(__ATOMIC_ACQUIRE, "agent");
            xb_add(&bar[XB_XGEN(b.x)], 1u);
            asm volatile("s_waitcnt vmcnt(0)" ::: "memory");
        } else {
            XB_SPIN(xb_ld(&bar[XB_XGEN(b.x)]) == gen, bar);
            __builtin_amdgcn_fence(__ATOMIC_ACQUIRE, "agent");
            asm volatile("s_waitcnt vmcnt(0)" ::: "memory");
        }
    }
    __syncthreads();
}

constexpr size_t MiB = 1u << 20;
constexpr size_t WS_CTL = 0, CTL_ZERO_BYTES = 1 * MiB;
constexpr size_t WS_WIN = 2 * MiB;
constexpr size_t WS_WA = 10 * MiB;
constexpr size_t WS_WPB = 11 * MiB;
constexpr size_t WS_WO = 12 * MiB;
constexpr size_t WS_WUP = 14 * MiB;
constexpr size_t WS_WDN = 25 * MiB;
constexpr size_t WS_RSTD1 = 31 * MiB;
constexpr size_t WS_SSQ = 32 * MiB;
constexpr size_t WS_HALO = 35 * MiB;
constexpr size_t WS_X1B = 58 * MiB;
constexpr size_t WS_RA = 123 * MiB;
constexpr size_t RA_XB = WS_RA;
constexpr size_t RA_QB = WS_RA + (size_t)M * 1024 * 2;
constexpr size_t RA_KB = RA_QB + (size_t)M * 512 * 2;
constexpr size_t RA_VB = RA_KB + (size_t)M * 512 * 2;
constexpr size_t RA_UB = RA_VB + (size_t)M * 512 * 2;
constexpr size_t RA_SG = RA_UB + (size_t)M * 512 * 4;
constexpr size_t RA_END = RA_SG + (size_t)M * 2048 * 2;
constexpr size_t RA_UP = WS_RA;
static_assert(RA_UP + (size_t)M * FF2 * 2 <= RA_END, "UP fits region A");
constexpr size_t WS_END = RA_END;
static_assert(WS_HALO + (size_t)(M / 32) * 2 * FF2 * 2 <= WS_X1B && WS_X1B + (size_t)M * 1024 * 2 <= WS_RA && WS_SSQ + (size_t)M * 64 <= WS_HALO, "ws map");
constexpr int CW_BAR = 4096;

constexpr int RING_BYTES = 131072;
constexpr int LDSCTL_OFF = RING_BYTES, MISC_OFF = LDSCTL_OFF + 320;
constexpr int LDS_BYTES = 147456;
constexpr int NWAVES = 8;

struct Args {
    const float* in[19]; float* out; unsigned char* ws;
};

__device__ __forceinline__ void p0_transpose_item(const float* W, const float* gk, int K, int N, bf16* WT, LAS float* scr, int item, int lane) {
    const int nblk = N / 32, kb = item / nblk, nb = item % nblk, k0 = 64 * kb, n0 = 32 * nb;
#pragma unroll 8
    for (int i = 0; i < 32; ++i) { const int kk = 2 * i + (lane >> 5); float v = W[(size_t)(k0 + kk) * N + n0 + (lane & 31)]; if (gk) v *= gk[k0 + kk]; scr[kk * 33 + (lane & 31)] = v; }
    LDS_WAIT(); asm volatile("" ::: "memory");
    const int c = lane & 7;
#pragma unroll
    for (int j = 0; j < 4; ++j) { const int n = (lane >> 3) + 8 * j; const LAS float* s = scr + (8 * c) * 33 + n;
        v4u o; o.x = pk2(s[0 * 33], s[1 * 33]); o.y = pk2(s[2 * 33], s[3 * 33]); o.z = pk2(s[4 * 33], s[5 * 33]); o.w = pk2(s[6 * 33], s[7 * 33]);
        *(GAS v4u*)(WT + (size_t)(n0 + n) * K + k0 + 8 * c) = o; }
    LDS_WAIT(); asm volatile("" ::: "memory");
}

namespace sb {
__device__ __forceinline__ int pi32(int i) { return 16 * ((i >> 2) & 1) + (i & 3) + 4 * (i >> 3); }
__device__ __forceinline__ unsigned cvtpk(float lo, float hi) { typedef float f2 __attribute__((ext_vector_type(2))); typedef __bf16 b2 __attribute__((ext_vector_type(2))); f2 v = {lo, hi}; b2 b = __builtin_convertvector(v, b2); return __builtin_bit_cast(unsigned, b); }

template <bool MASK>
__device__ __forceinline__ void block(f32x16& p, float& carry, int keybase, int tq, int hi, v4u& pa0, v4u& pa1) {
    float sp[16];
#pragma unroll
    for (int r = 0; r < 16; ++r) {
        const float zc = fminf(p[r], 126.0f);
        float s = __builtin_amdgcn_logf(1.0f + __builtin_amdgcn_exp2f(zc));
        if (MASK) s = (keybase + r >= tq) ? 0.f : s;
        sp[r] = s; p[r] = zc - s;
    }
    float run = 0.f;
#pragma unroll
    for (int r = 15; r >= 0; --r) { const float t = sp[r]; sp[r] = run; run += t; }
    const auto rr = __builtin_amdgcn_permlane32_swap(__float_as_uint(run), __float_as_uint(run), false, false);
    const float other = hi ? __uint_as_float(rr[0]) : __uint_as_float(rr[1]);
    const float base = carry + (hi ? 0.f : other);
#pragma unroll
    for (int r = 0; r < 16; ++r) {
        float a = __builtin_amdgcn_exp2f(p[r] - (base + sp[r]));
        if (MASK) a = (keybase + r >= tq) ? 0.f : a;
        p[r] = a;
    }
    carry += run + other;
    pa0 = (v4u){cvtpk(p[0], p[1]), cvtpk(p[2], p[3]), cvtpk(p[4], p[5]), cvtpk(p[6], p[7])};
    pa1 = (v4u){cvtpk(p[8], p[9]), cvtpk(p[10], p[11]), cvtpk(p[12], p[13]), cvtpk(p[14], p[15])};
}

template <bool MASK>
__device__ __forceinline__ void tile(const LAS unsigned char* Kt, const LAS unsigned char* Vt, const bf16x8 (&qr)[4], f32x16 (&o)[2], float& carry, int k0, int tq, int lane) {
    const int i = lane & 31, hi = lane >> 5;
    const int g1 = (lane >> 4) & 1, q4 = (lane & 15) >> 2, pp = lane & 3;
    const LAS unsigned char* kp = Kt + hi * 1024 + pi32(i) * 16;
    const LAS unsigned char* vp = Vt + (16 * hi + q4) * 64 + g1 * 32 + pp * 8;
    f32x16 p1 = {}, p0 = {};
#pragma unroll
    for (int d0 = 0; d0 < 4; ++d0) {
        const bf16x8 k1 = *(const LAS bf16x8*)(kp + d0 * 2048 + 512);
        const bf16x8 k0f = *(const LAS bf16x8*)(kp + d0 * 2048);
        p1 = __builtin_amdgcn_mfma_f32_32x32x16_bf16(k1, qr[d0], p1, 0, 0, 0);
        p0 = __builtin_amdgcn_mfma_f32_32x32x16_bf16(k0f, qr[d0], p0, 0, 0, 0);
    }
    v4u a10, a11, a00, a01;
    block<MASK>(p1, carry, k0 + 32 + 16 * hi, tq, hi, a10, a11);
    block<MASK>(p0, carry, k0 + 16 * hi, tq, hi, a00, a01);
#pragma unroll
    for (int d0 = 0; d0 < 2; ++d0) {
#pragma unroll
        for (int blk = 1; blk >= 0; --blk) {
#pragma unroll
            for (int s = 0; s < 2; ++s) {
                const LAS unsigned char* a = vp + d0 * 4096 + (32 * blk + 8 * s) * 64;
                const v4i16_t lo = __builtin_amdgcn_ds_read_tr16_b64_v4i16((LAS v4i16_t*)a);
                const v4i16_t hh = __builtin_amdgcn_ds_read_tr16_b64_v4i16((LAS v4i16_t*)(a + 256));
                const bf16x8 vf = {lo[0], lo[1], lo[2], lo[3], hh[0], hh[1], hh[2], hh[3]};
                const v4u pa = blk ? (s ? a11 : a10) : (s ? a01 : a00);
                o[d0] = __builtin_amdgcn_mfma_f32_32x32x16_bf16(__builtin_bit_cast(bf16x8, pa), vf, o[d0], 0, 0, 0);
            }
        }
    }
}
__device__ __forceinline__ int crow(int r, int hi) { return (r & 3) + 8 * (r >> 2) + 4 * hi; }

__device__ __forceinline__ void unit_prompt(LAS unsigned char* lds, int b, int h, int qb, const bf16* QB, const bf16* KB, const bf16* VB, bf16* ATT) {
    const int tid = threadIdx.x, lane = tid & 63, hi = lane >> 5; const int wid = __builtin_amdgcn_readfirstlane(tid >> 6);
    const size_t rowbase = (size_t)b * SEQ; const int q0 = qb * 256;
    const int tq = q0 + 32 * wid + (lane & 31);
    bf16x8 qr[4];
    { const bf16* qp = QB + (rowbase + tq) * AW + h * HD + hi * 8;
#pragma unroll
      for (int d0 = 0; d0 < 4; ++d0) qr[d0] = *(const bf16x8*)(qp + d0 * 16); }
    f32x16 o[2]; o[0] = f32x16{}; o[1] = f32x16{};
    float carry = 0.f;
    const int NT = 4 * (qb + 1);
    const bf16* ksrc = KB + (rowbase + (tid & 63)) * AW + h * HD + (tid >> 6) * 8;
    const bf16* vsrc = VB + (rowbase + ((tid & 255) >> 2)) * AW + h * HD + (tid >> 8) * 32 + (tid & 3) * 8;
    v4u kreg = *(const v4u*)(ksrc + (size_t)(NT - 1) * 64 * AW), vreg = *(const v4u*)(vsrc + (size_t)(NT - 1) * 64 * AW);
    *(LAS v4u*)(lds + tid * 16) = kreg; *(LAS v4u*)(lds + 8192 + tid * 16) = vreg;
    __syncthreads();
    const int tmin_q = q0 + 32 * wid;
    for (int t = NT - 1; t >= 0; --t) {
        const int cur = (NT - 1 - t) & 1;
        if (t > 0) { kreg = *(const v4u*)(ksrc + (size_t)(t - 1) * 64 * AW); vreg = *(const v4u*)(vsrc + (size_t)(t - 1) * 64 * AW); }
        const int k0 = 64 * t;
        const LAS unsigned char* Kt = lds + cur * 16384; const LAS unsigned char* Vt = Kt + 8192;
        if (k0 <= tmin_q + 30) {
            if (k0 + 64 <= tmin_q) tile<false>(Kt, Vt, qr, o, carry, k0, tq, lane);
            else tile<true>(Kt, Vt, qr, o, carry, k0, tq, lane);
        }
        if (t > 0) { *(LAS v4u*)(lds + (cur ^ 1) * 16384 + tid * 16) = kreg; *(LAS v4u*)(lds + (cur ^ 1) * 16384 + 8192 + tid * 16) = vreg; }
        __syncthreads();
    }
    bf16* op = ATT + (rowbase + q0 + 32 * wid) * AW + h * HD + (lane & 31);
#pragma unroll
    for (int d0 = 0; d0 < 2; ++d0)
#pragma unroll
        for (int r = 0; r < 16; ++r) op[(size_t)crow(r, hi) * AW + d0 * 32] = (bf16)f2bf(o[d0][r]);
}

__device__ __forceinline__ void unit_sample(LAS unsigned char* lds, int b, int h, const bf16* QB, const bf16* KB, const bf16* VB, const float* ck, const float* cv, bf16* ATT) {
    const int tid = threadIdx.x, lane = tid & 63, hi = lane >> 5; const int wid = __builtin_amdgcn_readfirstlane(tid >> 6);
    const size_t rowbase = (size_t)MP + (size_t)b * DEC_SEQ;
    const int tq = PAST + (lane & 15);
    bf16x8 qr[4];
    { const bf16* qp = QB + (rowbase + (lane & 15)) * AW + h * HD + hi * 8;
#pragma unroll
      for (int d0 = 0; d0 < 4; ++d0) qr[d0] = *(const bf16x8*)(qp + d0 * 16); }
    f32x16 o[2]; o[0] = f32x16{}; o[1] = f32x16{};
    float carry = 0.f;
    LAS unsigned char* Kt = lds + wid * 16384; LAS unsigned char* Vt = Kt + 8192;
    const int tlo = 2 * wid, thi = (wid == 7) ? 17 : 2 * wid + 2;
    const int rr = lane >> 4, pc = lane & 15;
    for (int t = thi - 1; t >= tlo; --t) {
        if (t < 16) {
            const float* kb_ = ck + (((size_t)b * PAST + (size_t)t * 64) * NH + h) * HD;
            const float* vb_ = cv + (((size_t)b * PAST + (size_t)t * 64) * NH + h) * HD;
#pragma unroll 4
            for (int it = 0; it < 16; ++it) {
                const int row = 4 * it + rr;
                const f32x4 kv = *(const f32x4*)(kb_ + (size_t)row * NH * HD + pc * 4);
                const f32x4 vv = *(const f32x4*)(vb_ + (size_t)row * NH * HD + pc * 4);
                v2u kw; kw.x = pk2(kv[0], kv[1]); kw.y = pk2(kv[2], kv[3]);
                v2u vw; vw.x = pk2(vv[0], vv[1]); vw.y = pk2(vv[2], vv[3]);
                *(LAS v2u*)(Kt + (pc >> 1) * 1024 + row * 16 + (pc & 1) * 8) = kw;
                *(LAS v2u*)(Vt + (pc >> 3) * 4096 + row * 64 + (pc & 7) * 8) = vw;
            }
        } else {
#pragma unroll 4
            for (int it = 0; it < 16; ++it) {
                const int row = 4 * it + rr;
                v2u kw = {0u, 0u}, vw = {0u, 0u};
                if (row < DEC_SEQ) { kw = *(const v2u*)(KB + (rowbase + row) * AW + h * HD + pc * 4); vw = *(const v2u*)(VB + (rowbase + row) * AW + h * HD + pc * 4); }
                *(LAS v2u*)(Kt + (pc >> 1) * 1024 + row * 16 + (pc & 1) * 8) = kw;
                *(LAS v2u*)(Vt + (pc >> 3) * 4096 + row * 64 + (pc & 7) * 8) = vw;
            }
        }
        LDS_WAIT();
        if (t < 16) tile<false>(Kt, Vt, qr, o, carry, 64 * t, tq, lane);
        else tile<true>(Kt, Vt, qr, o, carry, 64 * t, tq, lane);
        LDS_WAIT();
    }
    LAS float* Ow = (LAS float*)(lds + wid * 16384);
#pragma unroll
    for (int d0 = 0; d0 < 2; ++d0)
#pragma unroll
        for (int r = 0; r < 8; ++r) Ow[crow(r, hi) * 64 + d0 * 32 + (lane & 31)] = o[d0][r];
    if (lane < 16) Ow[1024 + lane] = carry;
    __syncthreads();
    {
        const int q = tid >> 5, dp = (tid & 31) * 2;
        float a0 = 0.f, a1 = 0.f, sc = 1.f;
#pragma unroll
        for (int w = 7; w >= 0; --w) {
            const LAS float* O = (const LAS float*)(lds + w * 16384);
            a0 += sc * O[q * 64 + dp]; a1 += sc * O[q * 64 + dp + 1];
            sc *= __builtin_amdgcn_exp2f(-O[1024 + q]);
        }
        *(unsigned*)(ATT + (rowbase + q) * AW + h * HD + dp) = pk2(a0, a1);
    }
    __syncthreads();
}
}

__global__ void __launch_bounds__(NWAVES * 64, 2) fwd_mega(Args args) {
    extern __shared__ __attribute__((aligned(16))) unsigned char lds_raw[];
    LAS unsigned char* lds = (LAS unsigned char*)lds_raw;
    volatile LAS unsigned* MISC = (volatile LAS unsigned*)(lds + MISC_OFF);
    const int tid = threadIdx.x, lane = tid & 63; const int wave = __builtin_amdgcn_readfirstlane(tid >> 6);
    const int G = gridDim.x; const int bx = blockIdx.x; const int vcu = (G % 8 == 0) ? (bx % 8) * (G / 8) + bx / 8 : bx;
    unsigned char* ws = args.ws; float* out = args.out;
    gu32* ctl = (gu32*)(ws + WS_CTL);
    const float* x_prompt = args.in[0]; const float* x_sample = args.in[1]; const float* cache_k = args.in[2]; const float* cache_v = args.in[3];
    const float* state_pool = args.in[4]; const float* state_conv = args.in[5]; const float* norm_mix = args.in[6]; const float* w_in = args.in[7];
    const float* w_a = args.in[8]; const float* w_b = args.in[9]; const float* pool_w = args.in[10]; const float* pool_scale = args.in[11];
    const float* w_o = args.in[12]; const float* norm_ffn = args.in[13]; const float* w_up = args.in[14]; const float* conv_w = args.in[15];
    const float* conv_b = args.in[16]; const float* w_down = args.in[17]; const float* norm_final = args.in[18];
    bf16* WIN = (bf16*)(ws + WS_WIN); bf16* WA = (bf16*)(ws + WS_WA); bf16* WPB = (bf16*)(ws + WS_WPB); bf16* WO = (bf16*)(ws + WS_WO);
    bf16* WUP = (bf16*)(ws + WS_WUP); bf16* WDN = (bf16*)(ws + WS_WDN);
    float* RSTD1 = (float*)(ws + WS_RSTD1); float* SSQ = (float*)(ws + WS_SSQ); bf16* HALO = (bf16*)(ws + WS_HALO); bf16* X1B = (bf16*)(ws + WS_X1B);
    bf16* XB = (bf16*)(ws + RA_XB); bf16* POOLED = (bf16*)(ws + RA_XB); bf16* QB = (bf16*)(ws + RA_QB); bf16* ATT = QB;
    bf16* KB = (bf16*)(ws + RA_KB); bf16* VB = (bf16*)(ws + RA_VB); bf16* MERGED = KB; float* UB = (float*)(ws + RA_UB); bf16* SG = (bf16*)(ws + RA_SG);
    bf16* UP = (bf16*)(ws + RA_UP);
    float* X1 = out + O_YP;

    for (int u = tid; u < (LDS_BYTES - LDSCTL_OFF) / 4; u += NWAVES * 64) ((LAS unsigned*)(lds + LDSCTL_OFF))[u] = 0u;
    __syncthreads();
    XcdBarrier bar = xcd_barrier_post((unsigned*)(ctl + CW_BAR), MISC + 8);
    const int gw = vcu * NWAVES + wave, NGW = G * NWAVES;
    const int gt = vcu * (NWAVES * 64) + tid, NGT = G * NWAVES * 64;

    {
        LAS float* scr = (LAS float*)(lds + wave * 16384);
        constexpr int I_IN = (D_MODEL / 64) * (INW / 32), I_A = (AW / 64) * (D_MODEL / 32), I_O = (D_MODEL / 64) * (D_MODEL / 32), I_UP = (D_MODEL / 64) * (FF2 / 32), I_DN = (DFF / 64) * (D_MODEL / 32);
        constexpr int NITEMS = I_IN + I_A + I_O + I_UP + I_DN;
        for (int it = gw; it < NITEMS; it += NGW) {
            int r = it;
            if (r < I_IN) { p0_transpose_item(w_in, norm_mix, D_MODEL, INW, WIN, scr, r, lane); continue; } r -= I_IN;
            if (r < I_A) { p0_transpose_item(w_a, nullptr, AW, D_MODEL, WA, scr, r, lane); continue; } r -= I_A;
            if (r < I_O) { p0_transpose_item(w_o, nullptr, D_MODEL, D_MODEL, WO, scr, r, lane); continue; } r -= I_O;
            if (r < I_UP) { p0_transpose_item(w_up, norm_ffn, D_MODEL, FF2, WUP, scr, r, lane); continue; } r -= I_UP;
            p0_transpose_item(w_down, nullptr, DFF, D_MODEL, WDN, scr, r, lane);
        }
        for (int task = gw; task < PW * (D_MODEL / 64); task += NGW) {
            const int kp = task / (D_MODEL / 64), n = (task % (D_MODEL / 64)) * 64 + lane; const int g = kp / PG;
            const float* pw = pool_w + (size_t)kp * PG;
            float s = 0.f;
#pragma unroll 8
            for (int d = 0; d < PG; ++d) s = fmaf(pw[d] * pool_scale[g * PG + d], w_b[(size_t)(g * PG + d) * D_MODEL + n], s);
            WPB[(size_t)n * PW + kp] = (bf16)f2bf(s);
        }
        for (int m = gw; m < M; m += NGW) {
            const float* xr = (m < MP) ? x_prompt + (size_t)m * D_MODEL : x_sample + (size_t)(m - MP) * D_MODEL;
            const GAS f32x4* xv = (const GAS f32x4*)xr + lane;
            f32x4 v[4]; float s = 0.f;
#pragma unroll
            for (int j = 0; j < 4; ++j) { v[j] = xv[64 * j]; s += (v[j].x * v[j].x + v[j].y * v[j].y) + (v[j].z * v[j].z + v[j].w * v[j].w); }
#pragma unroll
            for (int o = 1; o < 64; o <<= 1) s += __shfl_xor(s, o);
            if (lane == 0) RSTD1[m] = 1.0f / sqrtf(s * (1.0f / D_MODEL) + EPS);
            GAS v2u* o8 = (GAS v2u*)(XB + (size_t)m * D_MODEL) + lane;
#pragma unroll
            for (int j = 0; j < 4; ++j) { v2u w; w.x = pk2(v[j].x, v[j].y); w.y = pk2(v[j].z, v[j].w); o8[64 * j] = w; }
        }
    }
    xcd_barrier(bar);

    {
        pg8::Gemm g{XB, WIN, M, INW, D_MODEL, D_MODEL}; pg8::StaticOrder S; S.init(M, INW, G, bx);
        pg8::EpiIn E{RSTD1, QB, KB, VB, UB, SG, out};
        pg8::gemm_phase<pg8::EpiIn, pg8::StaticOrder, true>(lds, g, S, E);
    }
    xcd_barrier(bar);

    {
        if (G == 256) {
            const int bh = vcu >> 1, b = bh >> 3, h = bh & 7, s0 = (vcu & 1) * 2;
#pragma unroll 1
            for (int i = 0; i < 4; ++i) {
                const int s = s0 + (i >> 1); const int qb = (i & 1) ? 7 - s : s;
                sb::unit_prompt(lds, b, h, qb, QB, KB, VB, ATT);
            }
        } else {
            for (int u = vcu; u < BATCH * NH * 8; u += G) sb::unit_prompt(lds, (u >> 3) >> 3, (u >> 3) & 7, u & 7, QB, KB, VB, ATT);
        }
        for (int u = vcu; u < DEC_BATCH * NH; u += G) sb::unit_sample(lds, u >> 3, u & 7, QB, KB, VB, cache_k, cache_v, ATT);
        for (int task = gt; task < M * (PW / 4); task += NGT) {
            const int row = task >> 7, c = (task & 127) * 4; const int g = c >> 7, w = 2 << g;
            const bool prompt = row < MP; const int t = prompt ? (row & (SEQ - 1)) : ((row - MP) & 15);
            const int bs = prompt ? 0 : ((row - MP) >> 4);
            f32x4 s = {0.f, 0.f, 0.f, 0.f};
            const f32x4 own = *(const f32x4*)(UB + (size_t)row * PW + c);
            for (int j = 0; j < w; ++j) {
                const int tj = t - j;
                f32x4 v = {0.f, 0.f, 0.f, 0.f};
                if (tj >= 0) v = *(const f32x4*)(UB + (size_t)(row - j) * PW + c);
                else if (!prompt) v = *(const f32x4*)(state_pool + ((size_t)bs * PSTATE + (PSTATE + tj)) * PW + c);
                s += v;
            }
            const float inv = 1.0f / (float)(prompt ? min(t + 1, w) : w);
            const f32x4 pv = s * inv - own;
            v2u o; o.x = pk2(pv[0], pv[1]); o.y = pk2(pv[2], pv[3]);
            *(v2u*)(POOLED + (size_t)row * PW + c) = o;
            if (prompt) { if (t >= SEQ - PSTATE) *(f32x4*)(out + O_PP + ((size_t)(row >> 11) * PSTATE + (t - (SEQ - PSTATE))) * PW + c) = own; }
            else { if (t >= 1) *(f32x4*)(out + O_PS + ((size_t)bs * PSTATE + (t - 1)) * PW + c) = own; }
        }
    }
    xcd_barrier(bar);

    {
        pg8::Gemm g{ATT, WA, M, D_MODEL, AW, AW}; pg8::StaticOrder S; S.init(M, D_MODEL, G, bx);
        pg8::EpiGate<false> E{MERGED, SG, 0};
        pg8::gemm_phase<pg8::EpiGate<false>, pg8::StaticOrder, true>(lds, g, S, E);
    }
    {
        pg8::Gemm g{POOLED, WPB, M, D_MODEL, PW, PW}; pg8::StaticOrder S; S.init(M, D_MODEL, G, bx);
        pg8::EpiGate<true> E{MERGED, SG, 1024};
        pg8::gemm_phase<pg8::EpiGate<true>, pg8::StaticOrder, true>(lds, g, S, E);
    }
    xcd_barrier(bar);

    {
        pg8::Gemm g{MERGED, WO, M, D_MODEL, D_MODEL, D_MODEL}; pg8::StaticOrder S; S.init(M, D_MODEL, G, bx);
        pg8::EpiRes1 E{x_prompt, x_sample, X1, X1B, SSQ};
        pg8::gemm_phase<pg8::EpiRes1, pg8::StaticOrder, true>(lds, g, S, E);
    }
    xcd_barrier(bar);

    {
        pg8::Gemm g{X1B, WUP, M, FF2, D_MODEL, D_MODEL}; pg8::StaticOrder S; S.init(M, FF2, G, bx);
        pg8::EpiUp E{SSQ, UP, HALO, out};
        pg8::gemm_phase<pg8::EpiUp, pg8::StaticOrder, true>(lds, g, S, E);
    }
    xcd_barrier(bar);

    {
        constexpr int NSEG = M / 32, NCG = DFF / 8;
        for (int task = gt; task < NSEG * NCG; task += NGT) {
            const int seg = task / NCG, c = (task % NCG) * 8; const int r0 = seg * 32;
            const bool prompt = r0 < MP;
            float w0[16], w1[16], w2[16], cb[16], p2[16], p1[16];
#pragma unroll
            for (int hh = 0; hh < 2; ++hh)
#pragma unroll
                for (int e = 0; e < 8; e += 4) {
                    const int cc = c + hh * DFF + e;
                    const f32x4 a = *(const f32x4*)(conv_w + cc), b_ = *(const f32x4*)(conv_w + FF2 + cc), d = *(const f32x4*)(conv_w + 2 * FF2 + cc), bb = *(const f32x4*)(conv_b + cc);
#pragma unroll
                    for (int k = 0; k < 4; ++k) { w0[hh * 8 + e + k] = a[k]; w1[hh * 8 + e + k] = b_[k]; w2[hh * 8 + e + k] = d[k]; cb[hh * 8 + e + k] = bb[k]; }
                }
            if (prompt) {
                if ((r0 & (SEQ - 1)) == 0) {
#pragma unroll
                    for (int k = 0; k < 16; ++k) { p2[k] = 0.f; p1[k] = 0.f; }
                } else {
#pragma unroll
                    for (int hh = 0; hh < 2; ++hh) {
                        const v4u a = *(const v4u*)(HALO + ((size_t)(seg - 1) * 2 + 0) * FF2 + c + hh * DFF), b_ = *(const v4u*)(HALO + ((size_t)(seg - 1) * 2 + 1) * FF2 + c + hh * DFF);
                        p2[hh * 8 + 0] = bflo(a.x); p2[hh * 8 + 1] = bfhi(a.x); p2[hh * 8 + 2] = bflo(a.y); p2[hh * 8 + 3] = bfhi(a.y);
                        p2[hh * 8 + 4] = bflo(a.z); p2[hh * 8 + 5] = bfhi(a.z); p2[hh * 8 + 6] = bflo(a.w); p2[hh * 8 + 7] = bfhi(a.w);
                        p1[hh * 8 + 0] = bflo(b_.x); p1[hh * 8 + 1] = bfhi(b_.x); p1[hh * 8 + 2] = bflo(b_.y); p1[hh * 8 + 3] = bfhi(b_.y);
                        p1[hh * 8 + 4] = bflo(b_.z); p1[hh * 8 + 5] = bfhi(b_.z); p1[hh * 8 + 6] = bflo(b_.w); p1[hh * 8 + 7] = bfhi(b_.w);
                    }
                }
            }
#pragma unroll 2
            for (int i = 0; i < 32; ++i) {
                const int r = r0 + i;
                if (!prompt && (i & 15) == 0) {
                    const float* sc = state_conv + (size_t)((r - MP) >> 4) * 2 * FF2;
#pragma unroll
                    for (int hh = 0; hh < 2; ++hh)
#pragma unroll
                        for (int e = 0; e < 8; e += 4) {
                            const f32x4 a = *(const f32x4*)(sc + c + hh * DFF + e), b_ = *(const f32x4*)(sc + FF2 + c + hh * DFF + e);
#pragma unroll
                            for (int k = 0; k < 4; ++k) { p2[hh * 8 + e + k] = a[k]; p1[hh * 8 + e + k] = b_[k]; }
                        }
                }
                bf16* rowp = UP + (size_t)r * FF2 + c;
                const v4u gv = *(const v4u*)rowp, vv = *(const v4u*)(rowp + DFF);
                float cur[16];
                cur[0] = bflo(gv.x); cur[1] = bfhi(gv.x); cur[2] = bflo(gv.y); cur[3] = bfhi(gv.y); cur[4] = bflo(gv.z); cur[5] = bfhi(gv.z); cur[6] = bflo(gv.w); cur[7] = bfhi(gv.w);
                cur[8] = bflo(vv.x); cur[9] = bfhi(vv.x); cur[10] = bflo(vv.y); cur[11] = bfhi(vv.y); cur[12] = bflo(vv.z); cur[13] = bfhi(vv.z); cur[14] = bflo(vv.w); cur[15] = bfhi(vv.w);
                float act[8];
#pragma unroll
                for (int k = 0; k < 8; ++k) {
                    const float gt_ = cb[k] + w0[k] * p2[k] + w1[k] * p1[k] + w2[k] * cur[k];
                    const float vl = cb[8 + k] + w0[8 + k] * p2[8 + k] + w1[8 + k] * p1[8 + k] + w2[8 + k] * cur[8 + k];
                    const float inner = gt_ * (1.0f + 0.044715f * gt_ * gt_);
                    const float sg = __builtin_amdgcn_rcpf(1.0f + __builtin_amdgcn_exp2f(-2.0f * 0.7978845608028654f * 1.4426950408889634f * inner));
                    act[k] = gt_ * sg * vl;
                }
#pragma unroll
                for (int k = 0; k < 16; ++k) { p2[k] = p1[k]; p1[k] = cur[k]; }
                v4u o; o.x = pk2(act[0], act[1]); o.y = pk2(act[2], act[3]); o.z = pk2(act[4], act[5]); o.w = pk2(act[6], act[7]);
                *(v4u*)rowp = o;
            }
        }
    }
    xcd_barrier(bar);

    {
        pg8::Gemm g{UP, WDN, M, D_MODEL, DFF, FF2}; pg8::StaticOrder S; S.init(M, D_MODEL, G, bx);
        pg8::EpiRes2 E{X1};
        pg8::gemm_phase<pg8::EpiRes2, pg8::StaticOrder, true>(lds, g, S, E);
    }
    xcd_barrier(bar);

    for (int m = gw; m < M; m += NGW) {
        GAS f32x4* xv = (GAS f32x4*)(X1 + (size_t)m * D_MODEL) + lane;
        f32x4 v[4]; float s = 0.f;
#pragma unroll
        for (int j = 0; j < 4; ++j) { v[j] = xv[64 * j]; s += (v[j].x * v[j].x + v[j].y * v[j].y) + (v[j].z * v[j].z + v[j].w * v[j].w); }
#pragma unroll
        for (int o = 1; o < 64; o <<= 1) s += __shfl_xor(s, o);
        const float rs = 1.0f / sqrtf(s * (1.0f / D_MODEL) + EPS);
#pragma unroll
        for (int j = 0; j < 4; ++j) { const f32x4 gv = *((const f32x4*)norm_final + lane + 64 * j); xv[64 * j] = v[j] * rs * gv; }
    }
}

extern "C" void kernel_launch(void* const* d_in, const int* in_sizes, int n_in, void* d_out, int out_size, void* d_ws, size_t ws_size, hipStream_t stream) {
    static int grid = 0;
    if (grid == 0) {
        if (n_in != 19 || (size_t)out_size != O_END || ws_size < WS_END) {
            fprintf(stderr, "kernel_launch: unexpected sizes n_in %d out %d ws %zu (need %zu)\n", n_in, out_size, ws_size, (size_t)WS_END); grid = -1; return; }
        int dev = 0, cus = 0, per_cu = 0;
        if (hipGetDevice(&dev) != hipSuccess || hipDeviceGetAttribute(&cus, hipDeviceAttributeMultiprocessorCount, dev) != hipSuccess) { grid = -1; return; }
        if (hipFuncSetAttribute((const void*)fwd_mega, hipFuncAttributeMaxDynamicSharedMemorySize, LDS_BYTES) != hipSuccess) { fprintf(stderr, "kernel_launch: hipFuncSetAttribute failed\n"); grid = -1; return; }
        if (hipOccupancyMaxActiveBlocksPerMultiprocessor(&per_cu, (const void*)fwd_mega, NWAVES * 64, LDS_BYTES) != hipSuccess || per_cu < 1)
            fprintf(stderr, "kernel_launch: occupancy query reports %d blocks per CU\n", per_cu);
        (void)hipGetLastError();
        grid = cus;
    }
    if (grid < 0) return;
    (void)hipMemsetAsync((char*)d_ws + WS_CTL, 0, CTL_ZERO_BYTES, stream);
    Args a{};
    for (int i = 0; i < 19; ++i) a.in[i] = (const float*)d_in[i];
    a.out = (float*)d_out; a.ws = (unsigned char*)d_ws;
    hipLaunchKernelGGL(fwd_mega, dim3(grid), dim3(NWAVES * 64), LDS_BYTES, stream, a);
}
```

```cpp
#include <hip/hip_runtime.h>
#include <hip/hip_bf16.h>
#include <cstdio>
#include <cstdint>

constexpr int D_MODEL = 1024, BATCH = 16, SEQ = 2048, DEC_BATCH = 32, DEC_SEQ = 16, PAST = 1024;
constexpr int NH = 8, HD = 64, AW = 512, PW = 512, PG = 128, PSTATE = 15, DFF = 2816, FF2 = 5632, INW = 4096;
constexpr int MP = BATCH * SEQ, MS = DEC_BATCH * DEC_SEQ, M = MP + MS;
constexpr float EPS = 1e-6f;
constexpr float C2 = 0.125f * 1.4426950408889634f;

constexpr size_t O_YP = 0;
constexpr size_t O_YS = O_YP + (size_t)MP * D_MODEL;
constexpr size_t O_KP = O_YS + (size_t)MS * D_MODEL;
constexpr size_t O_VP = O_KP + (size_t)MP * AW;
constexpr size_t O_PP = O_VP + (size_t)MP * AW;
constexpr size_t O_CP = O_PP + (size_t)BATCH * PSTATE * PW;
constexpr size_t O_KS = O_CP + (size_t)BATCH * 2 * FF2;
constexpr size_t O_VS = O_KS + (size_t)MS * AW;
constexpr size_t O_PS = O_VS + (size_t)MS * AW;
constexpr size_t O_CS = O_PS + (size_t)DEC_BATCH * PSTATE * PW;
constexpr size_t O_END = O_CS + (size_t)DEC_BATCH * 2 * FF2;

namespace pg8 {
#define PG8_LAS __attribute__((address_space(3)))
typedef unsigned short bf16_t;
typedef short bf16x8 __attribute__((ext_vector_type(8)));
typedef float f32x4 __attribute__((ext_vector_type(4)));
typedef unsigned u32x4 __attribute__((ext_vector_type(4)));
constexpr int BM = 256, BK = 64, HALF = 128, HTB = HALF * BK * 2, STAGE_BYTES = 8 * HTB, NXCD = 8, WGM = 8;

__host__ __device__ __forceinline__ int lds_byte(int r, int c) { const int st = (r >> 4) * 2 + (c >> 5), rr = r & 15, cc = c & 31, ob = rr * 64 + cc * 2; return st * 1024 + (ob ^ (((ob >> 9) & 1) << 5)); }
__host__ __device__ __forceinline__ void stage_rc(int b, int& R, int& C) { const int st = b / 1024, sb = b % 1024, swz = sb ^ (((sb >> 9) & 1) << 5); R = (st >> 1) * 16 + swz / 64; C = (st & 1) * 32 + (swz % 64) / 2; }
__host__ __device__ __forceinline__ int perm32(int rho) { const int n = rho >> 4, i = rho & 15; return 8 * (i >> 2) + 4 * n + (i & 3); }

struct Unit { int pm, pn; };
struct Gemm { const bf16_t* A; const bf16_t* Bt; int M, N, K, lda; };

struct StaticOrder {
    int nM, nN, nwg, G, c;
    __host__ __device__ void init(int M_, int N_, int G_, int c_) { nM = M_ / BM; nN = N_ / BM; nwg = nM * nN; G = G_; c = c_; }
    __host__ __device__ bool next(int i, Unit& u) const {
        const long L = (long)i * G + c; if (L >= nwg) return false;
        int wgid = (int)L; { const int q = nwg / NXCD, r = nwg % NXCD, xcd = wgid % NXCD, off = wgid / NXCD; wgid = (xcd < r ? xcd * (q + 1) : r * (q + 1) + (xcd - r) * q) + off; }
        const int nig = WGM * nN, gid = wgid / nig, fm = gid * WGM, gsz = (nM - fm) < WGM ? (nM - fm) : WGM;
        u.pm = fm + ((wgid % nig) % gsz); u.pn = (wgid % nig) / gsz; return true;
    }
};

__device__ __forceinline__ unsigned cvt_pk_bf16(float lo, float hi) { unsigned r; asm volatile("v_cvt_pk_bf16_f32 %0, %1, %2" : "=v"(r) : "v"(lo), "v"(hi)); return r; }
__device__ __forceinline__ float bf_lo(unsigned u) { return __uint_as_float(u << 16); }
__device__ __forceinline__ float bf_hi(unsigned u) { return __uint_as_float(u & 0xffff0000u); }

template <class Epi, class Sched, bool ALIGN_EPI>
__device__ __forceinline__ void gemm_phase(PG8_LAS unsigned char* lds, const Gemm g, const Sched& S, const Epi& E) {
    const int tid = threadIdx.x, wid = __builtin_amdgcn_readfirstlane(tid >> 6), lane = tid & 63, wr = wid >> 2, wc = wid & 3, fr = lane & 15, fq = lane >> 4;
    const int K = g.K, nt = K / BK, lda = g.lda;
    unsigned voffA[2], voffB[2];
#pragma unroll
    for (int i = 0; i < 2; ++i) { int R, C; stage_rc(tid * 16 + i * 8192, R, C); const int Rb = Epi::PERM ? ((R & ~31) + perm32(R & 31)) : R;
        voffA[i] = (unsigned)(R * lda + C) * 2u; voffB[i] = (unsigned)(Rb * K + C) * 2u; }
    const size_t kstep = (size_t)(BK * 2);
    const size_t hstepA = (size_t)HALF * lda * 2, hstepB = (size_t)HALF * K * 2;
    const size_t tstepA = 2 * hstepA, tstepB = 2 * hstepB;
    const unsigned ldsw = (unsigned)wid * 1024u;
    const int aoff = lds_byte(wr * 64 + fr, fq * 8), boff = lds_byte(wc * 32 + fr, fq * 8);
#define PG8_SA(b, h) (((b) * 2 + (h)) * HTB)
#define PG8_SB(b, h) ((4 + (b) * 2 + (h)) * HTB)
#define PG8_STAGE(bufoff, gbase, voff) do { _Pragma("unroll") for (int _i = 0; _i < 2; ++_i) \
        __builtin_amdgcn_global_load_lds((const unsigned*)((const char*)(gbase) + (voff)[_i]), (PG8_LAS unsigned*)(lds + (bufoff) + ldsw + _i * 8192), 16, 0, 0); } while (0)
#define PG8_LDA(dst, b, h) do { _Pragma("unroll") for (int m = 0; m < 4; ++m) _Pragma("unroll") for (int k = 0; k < 2; ++k) dst[m][k] = *(const PG8_LAS bf16x8*)(lds + PG8_SA(b, h) + aoff + m * 2048 + k * 1024); } while (0)
#define PG8_LDB(dst, b, h) do { _Pragma("unroll") for (int n = 0; n < 2; ++n) _Pragma("unroll") for (int k = 0; k < 2; ++k) dst[n][k] = *(const PG8_LAS bf16x8*)(lds + PG8_SB(b, h) + boff + n * 2048 + k * 1024); } while (0)
#define PG8_MMA(ai, bj, At, Bt) do { __builtin_amdgcn_s_setprio(1); _Pragma("unroll") for (int m = 0; m < 4; ++m) _Pragma("unroll") for (int n = 0; n < 2; ++n) _Pragma("unroll") for (int k = 0; k < 2; ++k) \
        acc[ai][bj][m][n] = __builtin_amdgcn_mfma_f32_16x16x32_bf16(Bt[n][k], At[m][k], acc[ai][bj][m][n], 0, 0, 0); __builtin_amdgcn_s_setprio(0); } while (0)
#define PG8_WAIT_V(n) asm volatile("s_waitcnt vmcnt(" #n ")" ::: "memory")
#define PG8_WAIT_L(n) asm volatile("s_waitcnt lgkmcnt(" #n ")" ::: "memory")
#define PG8_BAR __builtin_amdgcn_s_barrier()
#define PG8_SCHED __builtin_amdgcn_sched_barrier(0)
    Unit cur, nxt; int ui = 0;
    if (!S.next(0, cur)) return;
    f32x4 acc[2][2][4][2];
#pragma unroll
    for (int a = 0; a < 2; ++a)
#pragma unroll
        for (int b = 0; b < 2; ++b)
#pragma unroll
            for (int m = 0; m < 4; ++m)
#pragma unroll
                for (int n = 0; n < 2; ++n) acc[a][b][m][n] = (f32x4){0.f, 0.f, 0.f, 0.f};
    bf16x8 At[4][2], B0[2][2], B1[2][2];
    const char* cA = (const char*)g.A + (size_t)cur.pm * tstepA; const char* cB = (const char*)g.Bt + (size_t)cur.pn * tstepB;
    PG8_STAGE(PG8_SB(0, 0), cB, voffB); PG8_STAGE(PG8_SB(0, 1), cB + hstepB, voffB); PG8_STAGE(PG8_SA(0, 0), cA, voffA); PG8_STAGE(PG8_SA(0, 1), cA + hstepA, voffA);
    if (wr == 1) PG8_BAR;
    PG8_WAIT_V(2); PG8_BAR;
    PG8_STAGE(PG8_SB(1, 0), cB + kstep, voffB); PG8_STAGE(PG8_SA(1, 0), cA + kstep, voffA); PG8_STAGE(PG8_SB(1, 1), cB + hstepB + kstep, voffB);
    PG8_WAIT_V(6); PG8_BAR;
    for (;;) {
        const bool has_next = S.next(ui + 1, nxt);
        const char* nA = has_next ? (const char*)g.A + (size_t)nxt.pm * tstepA : cA; const char* nB = has_next ? (const char*)g.Bt + (size_t)nxt.pn * tstepB : cB;
        for (int t = 0; t < nt; t += 2) {
            const bool last = (t == nt - 2);
            const char* a1 = cA + (size_t)(t + 1) * kstep;
            const char* a2 = last ? nA : cA + (size_t)(t + 2) * kstep; const char* b2 = last ? nB : cB + (size_t)(t + 2) * kstep;
            const char* a3 = a2 + kstep; const char* b3 = b2 + kstep;
            PG8_LDB(B0, 0, 0); PG8_LDB(B1, 0, 1); PG8_SCHED; PG8_LDA(At, 0, 0); PG8_STAGE(PG8_SA(1, 1), a1 + hstepA, voffA);
            PG8_WAIT_V(8); PG8_WAIT_L(0); PG8_BAR; PG8_MMA(0, 0, At, B0); PG8_MMA(0, 1, At, B1); PG8_BAR; PG8_SCHED;
            PG8_LDA(At, 0, 1); PG8_STAGE(PG8_SB(0, 0), b2, voffB); PG8_STAGE(PG8_SB(0, 1), b2 + hstepB, voffB); PG8_STAGE(PG8_SA(0, 0), a2, voffA);
            PG8_WAIT_V(8); PG8_WAIT_L(0); PG8_BAR; PG8_MMA(1, 0, At, B0); PG8_MMA(1, 1, At, B1); PG8_BAR; PG8_SCHED;
            PG8_LDB(B0, 1, 0); PG8_LDB(B1, 1, 1); PG8_SCHED; PG8_LDA(At, 1, 0); PG8_STAGE(PG8_SA(0, 1), a2 + hstepA, voffA);
            PG8_WAIT_V(8); PG8_WAIT_L(0); PG8_BAR; PG8_MMA(0, 0, At, B0); PG8_MMA(0, 1, At, B1); PG8_BAR; PG8_SCHED;
            PG8_LDA(At, 1, 1); PG8_STAGE(PG8_SB(1, 0), b3, voffB); PG8_STAGE(PG8_SB(1, 1), b3 + hstepB, voffB); PG8_STAGE(PG8_SA(1, 0), a3, voffA);
            PG8_WAIT_V(8); PG8_WAIT_L(0); PG8_BAR; PG8_MMA(1, 0, At, B0); PG8_MMA(1, 1, At, B1); PG8_BAR; PG8_SCHED;
        }
        if constexpr (ALIGN_EPI) { if (wr == 0) PG8_BAR; }
        E(acc, cur, wr, wc, fr, fq);
        if (!has_next) break;
#pragma unroll
        for (int a = 0; a < 2; ++a)
#pragma unroll
            for (int b = 0; b < 2; ++b)
#pragma unroll
                for (int m = 0; m < 4; ++m)
#pragma unroll
                    for (int n = 0; n < 2; ++n) acc[a][b][m][n] = (f32x4){0.f, 0.f, 0.f, 0.f};
        cur = nxt; cA = nA; cB = nB; ++ui;
        if constexpr (ALIGN_EPI) { if (wr == 1) PG8_BAR; }
    }
    PG8_WAIT_V(0);
    if constexpr (!ALIGN_EPI) { if (wr == 0) PG8_BAR; }
    PG8_BAR;
#undef PG8_SA
#undef PG8_SB
#undef PG8_STAGE
#undef PG8_LDA
#undef PG8_LDB
#undef PG8_MMA
#undef PG8_WAIT_V
#undef PG8_WAIT_L
#undef PG8_BAR
#undef PG8_SCHED
}

__device__ __forceinline__ float sigmoid_fast(float x) { return __builtin_amdgcn_rcpf(1.0f + __builtin_amdgcn_exp2f(-1.4426950408889634f * x)); }

struct EpiIn {
    static constexpr bool PERM = true;
    const float* rstd; bf16_t* QB; bf16_t* KB; bf16_t* VB; float* UB; bf16_t* SG; float* out;
    __device__ __forceinline__ void operator()(const f32x4 (&acc)[2][2][4][2], const Unit& u, int wr, int wc, int fr, int fq) const {
        const int pn = u.pn, pm = u.pm;
        bf16_t* db = nullptr; float* df = nullptr; int ldb = 0, ldf = 0, cbase = 0; float mult = 1.f; bool sig = false;
        if (pn < 2) { db = QB; ldb = AW; cbase = 0; mult = C2; }
        else if (pn < 4) { db = KB; ldb = AW; cbase = 512; df = (pm < MP / 256) ? out + O_KP : out + O_KS - (size_t)MP * AW; ldf = AW; }
        else if (pn < 6) { db = VB; ldb = AW; cbase = 1024; df = (pm < MP / 256) ? out + O_VP : out + O_VS - (size_t)MP * AW; ldf = AW; }
        else if (pn < 8) { df = UB; ldf = PW; cbase = 1536; }
        else { db = SG; ldb = 2048; cbase = 2048; sig = true; }
        const int row0 = pm * BM + wr * 64 + fr;
        const int col0 = pn * BM + wc * 32 + 8 * fq - cbase;
#pragma unroll
        for (int ai = 0; ai < 2; ++ai)
#pragma unroll
            for (int m = 0; m < 4; ++m) {
                const int row = row0 + ai * HALF + m * 16;
                const float rs = rstd[row] * mult;
#pragma unroll
                for (int bj = 0; bj < 2; ++bj) {
                    f32x4 v0 = acc[ai][bj][m][0] * rs, v1 = acc[ai][bj][m][1] * rs;
                    const int col = col0 + bj * HALF;
                    if (sig) {
#pragma unroll
                        for (int e = 0; e < 4; ++e) { v0[e] = sigmoid_fast(v0[e]); v1[e] = sigmoid_fast(v1[e]); }
                    }
                    if (db) { u32x4 w; w.x = cvt_pk_bf16(v0[0], v0[1]); w.y = cvt_pk_bf16(v0[2], v0[3]); w.z = cvt_pk_bf16(v1[0], v1[1]); w.w = cvt_pk_bf16(v1[2], v1[3]);
                        *(u32x4*)(db + (size_t)row * ldb + col) = w; }
                    if (df) { float* p = df + (size_t)row * ldf + col; *(f32x4*)p = v0; *(f32x4*)(p + 4) = v1; }
                }
            }
    }
};

template <bool ACCUM> struct EpiGate {
    static constexpr bool PERM = true;
    bf16_t* MG; const bf16_t* SG; int goff;
    __device__ __forceinline__ void operator()(const f32x4 (&acc)[2][2][4][2], const Unit& u, int wr, int wc, int fr, int fq) const {
        const int row0 = u.pm * BM + wr * 64 + fr, col0 = u.pn * BM + wc * 32 + 8 * fq;
#pragma unroll
        for (int ai = 0; ai < 2; ++ai)
#pragma unroll
            for (int m = 0; m < 4; ++m) {
                const int row = row0 + ai * HALF + m * 16;
#pragma unroll
                for (int bj = 0; bj < 2; ++bj) {
                    const int col = col0 + bj * HALF;
                    const u32x4 gv = *(const u32x4*)(SG + (size_t)row * 2048 + goff + col);
                    f32x4 v0 = acc[ai][bj][m][0], v1 = acc[ai][bj][m][1];
                    v0[0] *= bf_lo(gv.x); v0[1] *= bf_hi(gv.x); v0[2] *= bf_lo(gv.y); v0[3] *= bf_hi(gv.y);
                    v1[0] *= bf_lo(gv.z); v1[1] *= bf_hi(gv.z); v1[2] *= bf_lo(gv.w); v1[3] *= bf_hi(gv.w);
                    bf16_t* dp = MG + (size_t)row * D_MODEL + col;
                    if (ACCUM) { const u32x4 ov = *(const u32x4*)dp;
                        v0[0] += bf_lo(ov.x); v0[1] += bf_hi(ov.x); v0[2] += bf_lo(ov.y); v0[3] += bf_hi(ov.y);
                        v1[0] += bf_lo(ov.z); v1[1] += bf_hi(ov.z); v1[2] += bf_lo(ov.w); v1[3] += bf_hi(ov.w); }
                    u32x4 w; w.x = cvt_pk_bf16(v0[0], v0[1]); w.y = cvt_pk_bf16(v0[2], v0[3]); w.z = cvt_pk_bf16(v1[0], v1[1]); w.w = cvt_pk_bf16(v1[2], v1[3]);
                    *(u32x4*)dp = w;
                }
            }
    }
};

struct EpiRes1 {
    static constexpr bool PERM = true;
    const float* xp; const float* xs; float* X1; bf16_t* X1B; float* SSQ;
    __device__ __forceinline__ void operator()(const f32x4 (&acc)[2][2][4][2], const Unit& u, int wr, int wc, int fr, int fq) const {
        const int row0 = u.pm * BM + wr * 64 + fr, col0 = u.pn * BM + wc * 32 + 8 * fq;
        const float* xsrc = (u.pm < MP / 256) ? xp : xs - (size_t)MP * D_MODEL;
#pragma unroll
        for (int ai = 0; ai < 2; ++ai)
#pragma unroll
            for (int m = 0; m < 4; ++m) {
                const int row = row0 + ai * HALF + m * 16; float s = 0.f;
#pragma unroll
                for (int bj = 0; bj < 2; ++bj) {
                    const size_t off = (size_t)row * D_MODEL + col0 + bj * HALF;
                    const f32x4 x0 = *(const f32x4*)(xsrc + off), x1 = *(const f32x4*)(xsrc + off + 4);
                    const f32x4 v0 = acc[ai][bj][m][0] + x0, v1 = acc[ai][bj][m][1] + x1;
                    s += (v0[0] * v0[0] + v0[1] * v0[1]) + (v0[2] * v0[2] + v0[3] * v0[3]) + (v1[0] * v1[0] + v1[1] * v1[1]) + (v1[2] * v1[2] + v1[3] * v1[3]);
                    *(f32x4*)(X1 + off) = v0; *(f32x4*)(X1 + off + 4) = v1;
                    u32x4 w; w.x = cvt_pk_bf16(v0[0], v0[1]); w.y = cvt_pk_bf16(v0[2], v0[3]); w.z = cvt_pk_bf16(v1[0], v1[1]); w.w = cvt_pk_bf16(v1[2], v1[3]);
                    *(u32x4*)(X1B + off) = w;
                }
                s += __shfl_xor(s, 16); s += __shfl_xor(s, 32);
                if (fq == 0) SSQ[(size_t)row * 16 + u.pn * 4 + wc] = s;
            }
    }
};

struct EpiUp {
    static constexpr bool PERM = true;
    const float* SSQ; bf16_t* UP; bf16_t* HALO; float* out;
    __device__ __forceinline__ void operator()(const f32x4 (&acc)[2][2][4][2], const Unit& u, int wr, int wc, int fr, int fq) const {
        const int row0 = u.pm * BM + wr * 64 + fr, col0 = u.pn * BM + wc * 32 + 8 * fq;
        const bool prompt = u.pm < MP / 256;
#pragma unroll
        for (int ai = 0; ai < 2; ++ai)
#pragma unroll
            for (int m = 0; m < 4; ++m) {
                const int row = row0 + ai * HALF + m * 16;
                const f32x4* sp = (const f32x4*)(SSQ + (size_t)row * 16);
                const f32x4 s0 = sp[0], s1 = sp[1], s2 = sp[2], s3 = sp[3];
                const float ss = ((s0[0] + s0[1]) + (s0[2] + s0[3])) + ((s1[0] + s1[1]) + (s1[2] + s1[3])) + ((s2[0] + s2[1]) + (s2[2] + s2[3])) + ((s3[0] + s3[1]) + (s3[2] + s3[3]));
                const float rs = __builtin_amdgcn_rsqf(ss * (1.0f / D_MODEL) + EPS);
                const bool halo = (row & 31) >= 30;
                float* cdst = nullptr;
                if (prompt) { if ((row & (SEQ - 1)) >= SEQ - 2) cdst = out + O_CP + ((size_t)(row >> 11) * 2 + ((row & (SEQ - 1)) - (SEQ - 2))) * FF2; }
                else { if ((row & 15) >= 14) cdst = out + O_CS + ((size_t)((row - MP) >> 4) * 2 + ((row & 15) - 14)) * FF2; }
#pragma unroll
                for (int bj = 0; bj < 2; ++bj) {
                    const int col = col0 + bj * HALF;
                    const f32x4 v0 = acc[ai][bj][m][0] * rs, v1 = acc[ai][bj][m][1] * rs;
                    u32x4 w; w.x = cvt_pk_bf16(v0[0], v0[1]); w.y = cvt_pk_bf16(v0[2], v0[3]); w.z = cvt_pk_bf16(v1[0], v1[1]); w.w = cvt_pk_bf16(v1[2], v1[3]);
                    *(u32x4*)(UP + (size_t)row * FF2 + col) = w;
                    if (halo) *(u32x4*)(HALO + ((size_t)(row >> 5) * 2 + ((row & 31) - 30)) * FF2 + col) = w;
                    if (cdst) { *(f32x4*)(cdst + col) = v0; *(f32x4*)(cdst + col + 4) = v1; }
                }
            }
    }
};

struct EpiRes2 {
    static constexpr bool PERM = true;
    float* X;
    __device__ __forceinline__ void operator()(const f32x4 (&acc)[2][2][4][2], const Unit& u, int wr, int wc, int fr, int fq) const {
        const int row0 = u.pm * BM + wr * 64 + fr, col0 = u.pn * BM + wc * 32 + 8 * fq;
#pragma unroll
        for (int ai = 0; ai < 2; ++ai)
#pragma unroll
            for (int m = 0; m < 4; ++m) {
                const int row = row0 + ai * HALF + m * 16;
#pragma unroll
                for (int bj = 0; bj < 2; ++bj) {
                    float* p = X + (size_t)row * D_MODEL + col0 + bj * HALF;
                    const f32x4 x0 = *(const f32x4*)p, x1 = *(const f32x4*)(p + 4);
                    *(f32x4*)p = acc[ai][bj][m][0] + x0; *(f32x4*)(p + 4) = acc[ai][bj][m][1] + x1;
                }
            }
    }
};
}

#define GAS __attribute__((address_space(1)))
#define LAS __attribute__((address_space(3)))
typedef unsigned short bf16;
typedef unsigned v4u __attribute__((ext_vector_type(4)));
typedef unsigned v2u __attribute__((ext_vector_type(2)));
typedef float f32x4 __attribute__((ext_vector_type(4)));
typedef float f32x16 __attribute__((ext_vector_type(16)));
typedef short bf16x8 __attribute__((ext_vector_type(8)));
typedef short v4i16_t __attribute__((ext_vector_type(4)));
typedef GAS unsigned gu32;
#define RLX_AGENT __ATOMIC_RELAXED, __HIP_MEMORY_SCOPE_AGENT
#define LDS_WAIT() asm volatile("s_waitcnt lgkmcnt(0)" ::: "memory")
#define VM_WAIT() asm volatile("s_waitcnt vmcnt(0)" ::: "memory")
__device__ __forceinline__ unsigned f2bf(float f) { unsigned u = __builtin_bit_cast(unsigned, f); return (u + 0x7fffu + ((u >> 16) & 1u)) >> 16; }
__device__ __forceinline__ unsigned pk2(float lo, float hi) { return f2bf(lo) | (f2bf(hi) << 16); }
__device__ __forceinline__ float bflo(unsigned u) { return __uint_as_float(u << 16); }
__device__ __forceinline__ float bfhi(unsigned u) { return __uint_as_float(u & 0xffff0000u); }

#define XB_TMO      128
#define XB_XCNT(j)  (256  + 64 * (j))
#define XB_XSUB(j)  (1280 + 64 * (j))
#define XB_XGEN(j)  (2304 + 64 * (j))
#define XB_TOP      3328
#define XB_TOPGEN   3392
#define XCD_BAR_WORDS 3456
#define XB_SPIN_CAP (1u << 18)

__device__ __forceinline__ unsigned xb_ld(unsigned* p)              { return __hip_atomic_load(p, __ATOMIC_RELAXED, __HIP_MEMORY_SCOPE_AGENT); }
__device__ __forceinline__ unsigned xb_add(unsigned* p, unsigned v) { return __hip_atomic_fetch_add(p, v, __ATOMIC_RELAXED, __HIP_MEMORY_SCOPE_AGENT); }
__device__ __forceinline__ unsigned xb_xcc_id() { return (unsigned)__builtin_amdgcn_s_getreg((3 << 11) | 20) & 0xFu; }
#define XB_SPIN(cond, bar) do { unsigned _sp = 0; while (cond) { __builtin_amdgcn_s_sleep(1); \
    if ((++_sp & 255u) == 0u) { if (xb_ld(&(bar)[XB_TMO])) break; if (_sp > XB_SPIN_CAP) { atomicAdd(&(bar)[XB_TMO], 1u); break; } } } } while (0)

struct XcdBarrier { unsigned* bar; unsigned x; volatile LAS unsigned* st; };

__device__ __forceinline__ XcdBarrier xcd_barrier_post(unsigned* bar, volatile LAS unsigned* st) {
    XcdBarrier b; b.bar = bar; b.x = xb_xcc_id(); b.st = st;
    if (threadIdx.x == 0) (void)xb_add(&bar[XB_XCNT(b.x)], 1u);
    return b;
}
__device__ __forceinline__ void xcd_barrier_complete(unsigned* bar, unsigned x, unsigned& nloc, unsigned& nx) {
    const unsigned G = gridDim.x * gridDim.y * gridDim.z;
    unsigned sum, cnt, mine, sp = 0u;
    for (;;) {
        sum = 0u; cnt = 0u; mine = 0u;
#pragma unroll
        for (unsigned j = 0; j < 16; ++j) { const unsigned c = xb_ld(&bar[XB_XCNT(j)]); sum += c; cnt += (c > 0u) ? 1u : 0u; mine = (j == x) ? c : mine; }
        if (sum == G) break;
        __builtin_amdgcn_s_sleep(1);
        if ((++sp & 255u) == 0u) { if (xb_ld(&bar[XB_TMO])) break; if (sp > XB_SPIN_CAP) { atomicAdd(&bar[XB_TMO], 1u); break; } }
    }
    nloc = mine > 0u ? mine : 1u; nx = cnt > 0u ? cnt : 1u;
}
__device__ __forceinline__ void xcd_barrier(const XcdBarrier& b) {
    asm volatile("s_waitcnt vmcnt(0)" ::: "memory");
    __syncthreads();
    if (threadIdx.x == 0) {
        unsigned* bar = b.bar;
        __builtin_amdgcn_s_waitcnt(0);
        unsigned nloc = b.st[0], nx = b.st[1];
        if (nloc == 0u) { xcd_barrier_complete(bar, b.x, nloc, nx); b.st[0] = nloc; b.st[1] = nx; }
        const unsigned old = xb_add(&bar[XB_XSUB(b.x)], 1u);
        const unsigned gen = old / nloc;
        if (old + 1u == (gen + 1u) * nloc) {
            __builtin_amdgcn_fence(__ATOMIC_RELEASE, "agent");
            asm volatile("s_waitcnt vmcnt(0)" ::: "memory");
            const unsigned og = xb_add(&bar[XB_TOP], 1u);
            const unsigned tg = og / nx;
            if (og + 1u == (tg + 1u) * nx) xb_add(&bar[XB_TOPGEN], 1u);
            else XB_SPIN(xb_ld(&bar[XB_TOPGEN]) == tg, bar);
            __builtin_amdgcn_fence(__ATOMIC_ACQUIRE, "agent");
            xb_add(&bar[XB_XGEN(b.x)], 1u);
            asm volatile("s_waitcnt vmcnt(0)" ::: "memory");
        } else {
            XB_SPIN(xb_ld(&bar[XB_XGEN(b.x)]) == gen, bar);
            __builtin_amdgcn_fence(__ATOMIC_ACQUIRE, "agent");
            asm volatile("s_waitcnt vmcnt(0)" ::: "memory");
        }
    }
    __syncthreads();
}

constexpr size_t MiB = 1u << 20;
constexpr size_t WS_CTL = 0, CTL_ZERO_BYTES = 1 * MiB;
constexpr size_t WS_WIN = 2 * MiB;
constexpr size_t WS_WA = 10 * MiB;
constexpr size_t WS_WPB = 11 * MiB;
constexpr size_t WS_WO = 12 * MiB;
constexpr size_t WS_WUP = 14 * MiB;
constexpr size_t WS_WDN = 25 * MiB;
constexpr size_t WS_RSTD1 = 31 * MiB;
constexpr size_t WS_SSQ = 32 * MiB;
constexpr size_t WS_HALO = 35 * MiB;
constexpr size_t WS_X1B = 58 * MiB;
constexpr size_t WS_RA = 123 * MiB;
constexpr size_t RA_XB = WS_RA;
constexpr size_t RA_QB = WS_RA + (size_t)M * 1024 * 2;
constexpr size_t RA_KB = RA_QB + (size_t)M * 512 * 2;
constexpr size_t RA_VB = RA_KB + (size_t)M * 512 * 2;
constexpr size_t RA_UB = RA_VB + (size_t)M * 512 * 2;
constexpr size_t RA_SG = RA_UB + (size_t)M * 512 * 4;
constexpr size_t RA_END = RA_SG + (size_t)M * 2048 * 2;
constexpr size_t RA_UP = WS_RA;
static_assert(RA_UP + (size_t)M * FF2 * 2 <= RA_END, "UP fits region A");
constexpr size_t WS_END = RA_END;
static_assert(WS_HALO + (size_t)(M / 32) * 2 * FF2 * 2 <= WS_X1B && WS_X1B + (size_t)M * 1024 * 2 <= WS_RA && WS_SSQ + (size_t)M * 64 <= WS_HALO, "ws map");
constexpr int CW_BAR = 4096;

constexpr int RING_BYTES = 131072;
constexpr int LDSCTL_OFF = RING_BYTES, MISC_OFF = LDSCTL_OFF + 320;
constexpr int LDS_BYTES = 147456;
constexpr int NWAVES = 8;

struct Args {
    const float* in[19]; float* out; unsigned char* ws;
};
#ifndef PROBE_MASK
#define PROBE_MASK 0
#endif
#ifndef PROBE_MULT
#define PROBE_MULT 4
#endif

__device__ __forceinline__ void p0_transpose_item(const float* W, const float* gk, int K, int N, bf16* WT, LAS float* scr, int item, int lane) {
    const int nblk = N / 32, kb = item / nblk, nb = item % nblk, k0 = 64 * kb, n0 = 32 * nb;
#pragma unroll 8
    for (int i = 0; i < 32; ++i) { const int kk = 2 * i + (lane >> 5); float v = W[(size_t)(k0 + kk) * N + n0 + (lane & 31)]; if (gk) v *= gk[k0 + kk]; scr[kk * 33 + (lane & 31)] = v; }
    LDS_WAIT(); asm volatile("" ::: "memory");
    const int c = lane & 7;
#pragma unroll
    for (int j = 0; j < 4; ++j) { const int n = (lane >> 3) + 8 * j; const LAS float* s = scr + (8 * c) * 33 + n;
        v4u o; o.x = pk2(s[0 * 33], s[1 * 33]); o.y = pk2(s[2 * 33], s[3 * 33]); o.z = pk2(s[4 * 33], s[5 * 33]); o.w = pk2(s[6 * 33], s[7 * 33]);
        *(GAS v4u*)(WT + (size_t)(n0 + n) * K + k0 + 8 * c) = o; }
    LDS_WAIT(); asm volatile("" ::: "memory");
}

namespace sb {
__device__ __forceinline__ int pi32(int i) { return 16 * ((i >> 2) & 1) + (i & 3) + 4 * (i >> 3); }
__device__ __forceinline__ unsigned cvtpk(float lo, float hi) { typedef float f2 __attribute__((ext_vector_type(2))); typedef __bf16 b2 __attribute__((ext_vector_type(2))); f2 v = {lo, hi}; b2 b = __builtin_convertvector(v, b2); return __builtin_bit_cast(unsigned, b); }

template <bool MASK>
__device__ __forceinline__ void block(f32x16& p, float& carry, int keybase, int tq, int hi, v4u& pa0, v4u& pa1) {
    float sp[16];
#pragma unroll
    for (int r = 0; r < 16; ++r) {
        float e = __builtin_amdgcn_exp2f(__builtin_amdgcn_fmed3f(p[r], -3.0e38f, 126.0f));
        if (MASK) e = (keybase + r >= tq) ? 0.f : e;
        const float f = __builtin_amdgcn_rcpf(1.0f + e);
        sp[r] = f; p[r] = e * f;
    }
    float run = 1.0f;
#pragma unroll
    for (int r = 15; r >= 0; --r) { const float f = sp[r]; sp[r] = run; run *= f; }
    const float T = -__builtin_amdgcn_logf(run);
    const auto rr = __builtin_amdgcn_permlane32_swap(__float_as_uint(T), __float_as_uint(T), false, false);
    const float other = hi ? __uint_as_float(rr[0]) : __uint_as_float(rr[1]);
    const float F = __builtin_amdgcn_exp2f(-(carry + (hi ? 0.f : other)));
#pragma unroll
    for (int r = 0; r < 16; ++r) p[r] = p[r] * (sp[r] * F);
    carry += T + other;
    pa0 = (v4u){cvtpk(p[0], p[1]), cvtpk(p[2], p[3]), cvtpk(p[4], p[5]), cvtpk(p[6], p[7])};
    pa1 = (v4u){cvtpk(p[8], p[9]), cvtpk(p[10], p[11]), cvtpk(p[12], p[13]), cvtpk(p[14], p[15])};
}

template <bool MASK>
__device__ __forceinline__ void tile(const LAS unsigned char* Kt, const LAS unsigned char* Vt, const bf16x8 (&qr)[4], f32x16 (&o)[2], float& carry, int k0, int tq, int lane) {
    const int i = lane & 31, hi = lane >> 5;
    const int g1 = (lane >> 4) & 1, q4 = (lane & 15) >> 2, pp = lane & 3;
    const LAS unsigned char* kp = Kt + hi * 1024 + pi32(i) * 16;
    const LAS unsigned char* vp = Vt + (16 * hi + q4) * 64 + g1 * 32 + pp * 8;
    f32x16 p1 = {}, p0 = {};
#pragma unroll
    for (int d0 = 0; d0 < 4; ++d0) {
        const bf16x8 k1 = *(const LAS bf16x8*)(kp + d0 * 2048 + 512);
        const bf16x8 k0f = *(const LAS bf16x8*)(kp + d0 * 2048);
        p1 = __builtin_amdgcn_mfma_f32_32x32x16_bf16(k1, qr[d0], p1, 0, 0, 0);
        p0 = __builtin_amdgcn_mfma_f32_32x32x16_bf16(k0f, qr[d0], p0, 0, 0, 0);
    }
    v4u a10, a11, a00, a01;
    block<MASK>(p1, carry, k0 + 32 + 16 * hi, tq, hi, a10, a11);
    block<MASK>(p0, carry, k0 + 16 * hi, tq, hi, a00, a01);
#pragma unroll
    for (int d0 = 0; d0 < 2; ++d0) {
#pragma unroll
        for (int blk = 1; blk >= 0; --blk) {
#pragma unroll
            for (int s = 0; s < 2; ++s) {
                const LAS unsigned char* a = vp + d0 * 4096 + (32 * blk + 8 * s) * 64;
                const v4i16_t lo = __builtin_amdgcn_ds_read_tr16_b64_v4i16((LAS v4i16_t*)a);
                const v4i16_t hh = __builtin_amdgcn_ds_read_tr16_b64_v4i16((LAS v4i16_t*)(a + 256));
                const bf16x8 vf = {lo[0], lo[1], lo[2], lo[3], hh[0], hh[1], hh[2], hh[3]};
                const v4u pa = blk ? (s ? a11 : a10) : (s ? a01 : a00);
                o[d0] = __builtin_amdgcn_mfma_f32_32x32x16_bf16(__builtin_bit_cast(bf16x8, pa), vf, o[d0], 0, 0, 0);
            }
        }
    }
}
__device__ __forceinline__ int crow(int r, int hi) { return (r & 3) + 8 * (r >> 2) + 4 * hi; }

__device__ __forceinline__ void unit_prompt(LAS unsigned char* lds, int b, int h, int qb, const bf16* QB, const bf16* KB, const bf16* VB, bf16* ATT) {
    const int tid = threadIdx.x, lane = tid & 63, hi = lane >> 5; const int wid = __builtin_amdgcn_readfirstlane(tid >> 6);
    const size_t rowbase = (size_t)b * SEQ; const int q0 = qb * 256;
    const int tq = q0 + 32 * wid + (lane & 31);
    bf16x8 qr[4];
    { const bf16* qp = QB + (rowbase + tq) * AW + h * HD + hi * 8;
#pragma unroll
      for (int d0 = 0; d0 < 4; ++d0) qr[d0] = *(const bf16x8*)(qp + d0 * 16); }
    f32x16 o[2]; o[0] = f32x16{}; o[1] = f32x16{};
    float carry = 0.f;
    const int NT = 4 * (qb + 1);
    const bf16* ksrc = KB + (rowbase + (tid & 63)) * AW + h * HD + (tid >> 6) * 8;
    const bf16* vsrc = VB + (rowbase + ((tid & 255) >> 2)) * AW + h * HD + (tid >> 8) * 32 + (tid & 3) * 8;
    v4u kreg = *(const v4u*)(ksrc + (size_t)(NT - 1) * 64 * AW), vreg = *(const v4u*)(vsrc + (size_t)(NT - 1) * 64 * AW);
    *(LAS v4u*)(lds + tid * 16) = kreg; *(LAS v4u*)(lds + 8192 + tid * 16) = vreg;
    __syncthreads();
    const int tmin_q = q0 + 32 * wid;
    for (int t = NT - 1; t >= 0; --t) {
        const int cur = (NT - 1 - t) & 1;
        if (t > 0) { kreg = *(const v4u*)(ksrc + (size_t)(t - 1) * 64 * AW); vreg = *(const v4u*)(vsrc + (size_t)(t - 1) * 64 * AW); }
        const int k0 = 64 * t;
        const LAS unsigned char* Kt = lds + cur * 16384; const LAS unsigned char* Vt = Kt + 8192;
        if (k0 <= tmin_q + 30) {
            if (k0 + 64 <= tmin_q) tile<false>(Kt, Vt, qr, o, carry, k0, tq, lane);
            else tile<true>(Kt, Vt, qr, o, carry, k0, tq, lane);
        }
        if (t > 0) { *(LAS v4u*)(lds + (cur ^ 1) * 16384 + tid * 16) = kreg; *(LAS v4u*)(lds + (cur ^ 1) * 16384 + 8192 + tid * 16) = vreg; }
        __syncthreads();
    }
    bf16* op = ATT + (rowbase + q0 + 32 * wid) * AW + h * HD + (lane & 31);
#pragma unroll
    for (int d0 = 0; d0 < 2; ++d0)
#pragma unroll
        for (int r = 0; r < 16; ++r) op[(size_t)crow(r, hi) * AW + d0 * 32] = (bf16)f2bf(o[d0][r]);
}

__device__ __forceinline__ void unit_sample(LAS unsigned char* lds, int b, int h, const bf16* QB, const bf16* KB, const bf16* VB, const float* ck, const float* cv, bf16* ATT) {
    const int tid = threadIdx.x, lane = tid & 63, hi = lane >> 5; const int wid = __builtin_amdgcn_readfirstlane(tid >> 6);
    const size_t rowbase = (size_t)MP + (size_t)b * DEC_SEQ;
    const int tq = PAST + (lane & 15);
    bf16x8 qr[4];
    { const bf16* qp = QB + (rowbase + (lane & 15)) * AW + h * HD + hi * 8;
#pragma unroll
      for (int d0 = 0; d0 < 4; ++d0) qr[d0] = *(const bf16x8*)(qp + d0 * 16); }
    f32x16 o[2]; o[0] = f32x16{}; o[1] = f32x16{};
    float carry = 0.f;
    LAS unsigned char* Kt = lds + wid * 16384; LAS unsigned char* Vt = Kt + 8192;
    const int tlo = 2 * wid, thi = (wid == 7) ? 17 : 2 * wid + 2;
    const int rr = lane >> 4, pc = lane & 15;
    for (int t = thi - 1; t >= tlo; --t) {
        if (t < 16) {
            const float* kb_ = ck + (((size_t)b * PAST + (size_t)t * 64) * NH + h) * HD;
            const float* vb_ = cv + (((size_t)b * PAST + (size_t)t * 64) * NH + h) * HD;
#pragma unroll 8
            for (int it = 0; it < 16; ++it) {
                const int row = 4 * it + rr;
                const f32x4 kv = *(const f32x4*)(kb_ + (size_t)row * NH * HD + pc * 4);
                const f32x4 vv = *(const f32x4*)(vb_ + (size_t)row * NH * HD + pc * 4);
                v2u kw; kw.x = pk2(kv[0], kv[1]); kw.y = pk2(kv[2], kv[3]);
                v2u vw; vw.x = pk2(vv[0], vv[1]); vw.y = pk2(vv[2], vv[3]);
                *(LAS v2u*)(Kt + (pc >> 1) * 1024 + row * 16 + (pc & 1) * 8) = kw;
                *(LAS v2u*)(Vt + (pc >> 3) * 4096 + row * 64 + (pc & 7) * 8) = vw;
            }
        } else {
#pragma unroll 4
            for (int it = 0; it < 16; ++it) {
                const int row = 4 * it + rr;
                v2u kw = {0u, 0u}, vw = {0u, 0u};
                if (row < DEC_SEQ) { kw = *(const v2u*)(KB + (rowbase + row) * AW + h * HD + pc * 4); vw = *(const v2u*)(VB + (rowbase + row) * AW + h * HD + pc * 4); }
                *(LAS v2u*)(Kt + (pc >> 1) * 1024 + row * 16 + (pc & 1) * 8) = kw;
                *(LAS v2u*)(Vt + (pc >> 3) * 4096 + row * 64 + (pc & 7) * 8) = vw;
            }
        }
        LDS_WAIT();
        if (t < 16) tile<false>(Kt, Vt, qr, o, carry, 64 * t, tq, lane);
        else tile<true>(Kt, Vt, qr, o, carry, 64 * t, tq, lane);
        LDS_WAIT();
    }
    LAS float* Ow = (LAS float*)(lds + wid * 16384);
#pragma unroll
    for (int d0 = 0; d0 < 2; ++d0)
#pragma unroll
        for (int r = 0; r < 8; ++r) Ow[crow(r, hi) * 64 + d0 * 32 + (lane & 31)] = o[d0][r];
    if (lane < 16) Ow[1024 + lane] = carry;
    __syncthreads();
    {
        const int q = tid >> 5, dp = (tid & 31) * 2;
        float a0 = 0.f, a1 = 0.f, sc = 1.f;
#pragma unroll
        for (int w = 7; w >= 0; --w) {
            const LAS float* O = (const LAS float*)(lds + w * 16384);
            a0 += sc * O[q * 64 + dp]; a1 += sc * O[q * 64 + dp + 1];
            sc *= __builtin_amdgcn_exp2f(-O[1024 + q]);
        }
        *(unsigned*)(ATT + (rowbase + q) * AW + h * HD + dp) = pk2(a0, a1);
    }
    __syncthreads();
}
}

template <int W>
__device__ __forceinline__ void pool_chunk(int ch, int c, const float* UB, const float* state_pool, bf16* POOLED, float* out) {
    const int r0 = ch * 16; const bool prompt = r0 < MP;
    const int t0 = prompt ? (r0 & (SEQ - 1)) : 0;
    const int bs = prompt ? 0 : ((r0 - MP) >> 4);
    f32x4 v[16 + W - 1];
#pragma unroll
    for (int k = 0; k < W - 1; ++k) {
        const int back = W - 1 - k;
        f32x4 x = {0.f, 0.f, 0.f, 0.f};
        if (prompt) { if (t0 - back >= 0) x = *(const f32x4*)(UB + (size_t)(r0 - back) * PW + c); }
        else x = *(const f32x4*)(state_pool + ((size_t)bs * PSTATE + (PSTATE - back)) * PW + c);
        v[k] = x;
    }
#pragma unroll
    for (int i = 0; i < 16; ++i) v[W - 1 + i] = *(const f32x4*)(UB + (size_t)(r0 + i) * PW + c);
#pragma unroll
    for (int i = 0; i < 16; ++i) {
        f32x4 s = v[i];
#pragma unroll
        for (int j = 1; j < W; ++j) s += v[i + j];
        const int t = t0 + i;
        const float inv = 1.0f / (float)(prompt ? min(t + 1, W) : W);
        const f32x4 own = v[W - 1 + i];
        const f32x4 pv = s * inv - own;
        v2u o; o.x = pk2(pv[0], pv[1]); o.y = pk2(pv[2], pv[3]);
        *(v2u*)(POOLED + (size_t)(r0 + i) * PW + c) = o;
        if (prompt) { if (t >= SEQ - PSTATE) *(f32x4*)(out + O_PP + ((size_t)(r0 >> 11) * PSTATE + (t - (SEQ - PSTATE))) * PW + c) = own; }
        else { if (i >= 1) *(f32x4*)(out + O_PS + ((size_t)bs * PSTATE + (i - 1)) * PW + c) = own; }
    }
}

__global__ void __launch_bounds__(NWAVES * 64, 2) fwd_mega(Args args) {
    extern __shared__ __attribute__((aligned(16))) unsigned char lds_raw[];
    LAS unsigned char* lds = (LAS unsigned char*)lds_raw;
    volatile LAS unsigned* MISC = (volatile LAS unsigned*)(lds + MISC_OFF);
    const int tid = threadIdx.x, lane = tid & 63; const int wave = __builtin_amdgcn_readfirstlane(tid >> 6);
    const int G = gridDim.x; const int bx = blockIdx.x; const int vcu = (G % 8 == 0) ? (bx % 8) * (G / 8) + bx / 8 : bx;
    unsigned char* ws = args.ws; float* out = args.out;
    gu32* ctl = (gu32*)(ws + WS_CTL);
    const float* x_prompt = args.in[0]; const float* x_sample = args.in[1]; const float* cache_k = args.in[2]; const float* cache_v = args.in[3];
    const float* state_pool = args.in[4]; const float* state_conv = args.in[5]; const float* norm_mix = args.in[6]; const float* w_in = args.in[7];
    const float* w_a = args.in[8]; const float* w_b = args.in[9]; const float* pool_w = args.in[10]; const float* pool_scale = args.in[11];
    const float* w_o = args.in[12]; const float* norm_ffn = args.in[13]; const float* w_up = args.in[14]; const float* conv_w = args.in[15];
    const float* conv_b = args.in[16]; const float* w_down = args.in[17]; const float* norm_final = args.in[18];
    bf16* WIN = (bf16*)(ws + WS_WIN); bf16* WA = (bf16*)(ws + WS_WA); bf16* WPB = (bf16*)(ws + WS_WPB); bf16* WO = (bf16*)(ws + WS_WO);
    bf16* WUP = (bf16*)(ws + WS_WUP); bf16* WDN = (bf16*)(ws + WS_WDN);
    float* RSTD1 = (float*)(ws + WS_RSTD1); float* SSQ = (float*)(ws + WS_SSQ); bf16* HALO = (bf16*)(ws + WS_HALO); bf16* X1B = (bf16*)(ws + WS_X1B);
    bf16* XB = (bf16*)(ws + RA_XB); bf16* POOLED = (bf16*)(ws + RA_XB); bf16* QB = (bf16*)(ws + RA_QB); bf16* ATT = QB;
    bf16* KB = (bf16*)(ws + RA_KB); bf16* VB = (bf16*)(ws + RA_VB); bf16* MERGED = KB; float* UB = (float*)(ws + RA_UB); bf16* SG = (bf16*)(ws + RA_SG);
    bf16* UP = (bf16*)(ws + RA_UP);
    float* X1 = out + O_YP;

    for (int u = tid; u < (LDS_BYTES - LDSCTL_OFF) / 4; u += NWAVES * 64) ((LAS unsigned*)(lds + LDSCTL_OFF))[u] = 0u;
    __syncthreads();
    XcdBarrier bar = xcd_barrier_post((unsigned*)(ctl + CW_BAR), MISC + 8);
    unsigned long long ts_prev = 0ull, ts_acc = 0ull; int ts_k = 0;
#define STAMP() do { if (PROBE_MASK) { if (bx == 0 && tid == 0) { const unsigned long long t_ = __builtin_amdgcn_s_memrealtime(); if ((PROBE_MASK >> ts_k) & 1) ts_acc += t_ - ts_prev; ts_prev = t_; } ++ts_k; } } while (0)
    if (PROBE_MASK && bx == 0 && tid == 0) ts_prev = __builtin_amdgcn_s_memrealtime();
    const int gw = vcu * NWAVES + wave, NGW = G * NWAVES;
    const int gt = vcu * (NWAVES * 64) + tid, NGT = G * NWAVES * 64;

    {
        LAS float* scr = (LAS float*)(lds + wave * 16384);
        constexpr int I_IN = (D_MODEL / 64) * (INW / 32), I_A = (AW / 64) * (D_MODEL / 32), I_O = (D_MODEL / 64) * (D_MODEL / 32), I_UP = (D_MODEL / 64) * (FF2 / 32), I_DN = (DFF / 64) * (D_MODEL / 32);
        constexpr int NITEMS = I_IN + I_A + I_O + I_UP + I_DN;
        for (int it = gw; it < NITEMS; it += NGW) {
            int r = it;
            if (r < I_IN) { p0_transpose_item(w_in, norm_mix, D_MODEL, INW, WIN, scr, r, lane); continue; } r -= I_IN;
            if (r < I_A) { p0_transpose_item(w_a, nullptr, AW, D_MODEL, WA, scr, r, lane); continue; } r -= I_A;
            if (r < I_O) { p0_transpose_item(w_o, nullptr, D_MODEL, D_MODEL, WO, scr, r, lane); continue; } r -= I_O;
            if (r < I_UP) { p0_transpose_item(w_up, norm_ffn, D_MODEL, FF2, WUP, scr, r, lane); continue; } r -= I_UP;
            p0_transpose_item(w_down, nullptr, DFF, D_MODEL, WDN, scr, r, lane);
        }
        for (int task = gw; task < 4 * 32 * 16; task += NGW) {
            const int g = task >> 9, c0 = ((task >> 4) & 31) * 4, n = (task & 15) * 64 + lane;
            const float* pw = pool_w + ((size_t)g * PG + c0) * PG; const float* ps = pool_scale + g * PG; const float* wb = w_b + (size_t)g * PG * D_MODEL + n;
            float s0 = 0.f, s1 = 0.f, s2 = 0.f, s3 = 0.f;
#pragma unroll 16
            for (int d = 0; d < PG; ++d) { const float wv = wb[(size_t)d * D_MODEL] * ps[d];
                s0 = fmaf(pw[d], wv, s0); s1 = fmaf(pw[PG + d], wv, s1); s2 = fmaf(pw[2 * PG + d], wv, s2); s3 = fmaf(pw[3 * PG + d], wv, s3); }
            v2u o; o.x = pk2(s0, s1); o.y = pk2(s2, s3);
            *(v2u*)(WPB + (size_t)n * PW + g * PG + c0) = o;
        }
        for (int m = gw; m < M; m += 2 * NGW) {
            const int m2 = m + NGW; const bool has2 = m2 < M; const int mm2 = has2 ? m2 : m;
            const float* xr = (m < MP) ? x_prompt + (size_t)m * D_MODEL : x_sample + (size_t)(m - MP) * D_MODEL;
            const float* xr2 = (mm2 < MP) ? x_prompt + (size_t)mm2 * D_MODEL : x_sample + (size_t)(mm2 - MP) * D_MODEL;
            const GAS f32x4* xv = (const GAS f32x4*)xr + lane; const GAS f32x4* xv2 = (const GAS f32x4*)xr2 + lane;
            f32x4 v[4], u[4]; float s = 0.f, s2 = 0.f;
#pragma unroll
            for (int j = 0; j < 4; ++j) { v[j] = xv[64 * j]; u[j] = xv2[64 * j]; }
#pragma unroll
            for (int j = 0; j < 4; ++j) { s += (v[j].x * v[j].x + v[j].y * v[j].y) + (v[j].z * v[j].z + v[j].w * v[j].w); s2 += (u[j].x * u[j].x + u[j].y * u[j].y) + (u[j].z * u[j].z + u[j].w * u[j].w); }
#pragma unroll
            for (int o = 1; o < 64; o <<= 1) { s += __shfl_xor(s, o); s2 += __shfl_xor(s2, o); }
            if (lane == 0) { RSTD1[m] = 1.0f / sqrtf(s * (1.0f / D_MODEL) + EPS); if (has2) RSTD1[m2] = 1.0f / sqrtf(s2 * (1.0f / D_MODEL) + EPS); }
            GAS v2u* o8 = (GAS v2u*)(XB + (size_t)m * D_MODEL) + lane;
#pragma unroll
            for (int j = 0; j < 4; ++j) { v2u w; w.x = pk2(v[j].x, v[j].y); w.y = pk2(v[j].z, v[j].w); o8[64 * j] = w; }
            if (has2) { GAS v2u* o82 = (GAS v2u*)(XB + (size_t)m2 * D_MODEL) + lane;
#pragma unroll
                for (int j = 0; j < 4; ++j) { v2u w; w.x = pk2(u[j].x, u[j].y); w.y = pk2(u[j].z, u[j].w); o82[64 * j] = w; } }
        }
    }
    xcd_barrier(bar); STAMP();

    {
        pg8::Gemm g{XB, WIN, M, INW, D_MODEL, D_MODEL}; pg8::StaticOrder S; S.init(M, INW, G, bx);
        pg8::EpiIn E{RSTD1, QB, KB, VB, UB, SG, out};
        pg8::gemm_phase<pg8::EpiIn, pg8::StaticOrder, true>(lds, g, S, E);
    }
    xcd_barrier(bar); STAMP();

    {
        if (G == 256) {
            const int bh = vcu >> 1, b = bh >> 3, h = bh & 7, s0 = (vcu & 1) * 2;
#pragma unroll 1
            for (int i = 0; i < 4; ++i) {
                const int s = s0 + (i >> 1); const int qb = (i & 1) ? 7 - s : s;
                sb::unit_prompt(lds, b, h, qb, QB, KB, VB, ATT);
            }
        } else {
            for (int u = vcu; u < BATCH * NH * 8; u += G) sb::unit_prompt(lds, (u >> 3) >> 3, (u >> 3) & 7, u & 7, QB, KB, VB, ATT);
        }
        for (int u = vcu; u < DEC_BATCH * NH; u += G) sb::unit_sample(lds, u >> 3, u & 7, QB, KB, VB, cache_k, cache_v, ATT);
        for (int task = gt; task < (M / 16) * (PW / 4); task += NGT) {
            const int ch = task >> 7, c = (task & 127) * 4;
            switch (c >> 7) {
                case 0: pool_chunk<2>(ch, c, UB, state_pool, POOLED, out); break;
                case 1: pool_chunk<4>(ch, c, UB, state_pool, POOLED, out); break;
                case 2: pool_chunk<8>(ch, c, UB, state_pool, POOLED, out); break;
                default: pool_chunk<16>(ch, c, UB, state_pool, POOLED, out); break;
            }
        }
    }
    xcd_barrier(bar); STAMP();

    {
        pg8::Gemm g{ATT, WA, M, D_MODEL, AW, AW}; pg8::StaticOrder S; S.init(M, D_MODEL, G, bx);
        pg8::EpiGate<false> E{MERGED, SG, 0};
        pg8::gemm_phase<pg8::EpiGate<false>, pg8::StaticOrder, true>(lds, g, S, E);
    }
    {
        pg8::Gemm g{POOLED, WPB, M, D_MODEL, PW, PW}; pg8::StaticOrder S; S.init(M, D_MODEL, G, bx);
        pg8::EpiGate<true> E{MERGED, SG, 1024};
        pg8::gemm_phase<pg8::EpiGate<true>, pg8::StaticOrder, true>(lds, g, S, E);
    }
    xcd_barrier(bar); STAMP();

    {
        pg8::Gemm g{MERGED, WO, M, D_MODEL, D_MODEL, D_MODEL}; pg8::StaticOrder S; S.init(M, D_MODEL, G, bx);
        pg8::EpiRes1 E{x_prompt, x_sample, X1, X1B, SSQ};
        pg8::gemm_phase<pg8::EpiRes1, pg8::StaticOrder, true>(lds, g, S, E);
    }
    xcd_barrier(bar); STAMP();

    {
        pg8::Gemm g{X1B, WUP, M, FF2, D_MODEL, D_MODEL}; pg8::StaticOrder S; S.init(M, FF2, G, bx);
        pg8::EpiUp E{SSQ, UP, HALO, out};
        pg8::gemm_phase<pg8::EpiUp, pg8::StaticOrder, true>(lds, g, S, E);
    }
    xcd_barrier(bar); STAMP();

    {
        constexpr int NSEG = M / 32, NCG = DFF / 8;
        for (int task = gt; task < NSEG * NCG; task += NGT) {
            const int seg = task / NCG, c = (task % NCG) * 8; const int r0 = seg * 32;
            const bool prompt = r0 < MP;
            float w0[16], w1[16], w2[16], cb[16], p2[16], p1[16];
#pragma unroll
            for (int hh = 0; hh < 2; ++hh)
#pragma unroll
                for (int e = 0; e < 8; e += 4) {
                    const int cc = c + hh * DFF + e;
                    const f32x4 a = *(const f32x4*)(conv_w + cc), b_ = *(const f32x4*)(conv_w + FF2 + cc), d = *(const f32x4*)(conv_w + 2 * FF2 + cc), bb = *(const f32x4*)(conv_b + cc);
#pragma unroll
                    for (int k = 0; k < 4; ++k) { w0[hh * 8 + e + k] = a[k]; w1[hh * 8 + e + k] = b_[k]; w2[hh * 8 + e + k] = d[k]; cb[hh * 8 + e + k] = bb[k]; }
                }
            if (prompt) {
                if ((r0 & (SEQ - 1)) == 0) {
#pragma unroll
                    for (int k = 0; k < 16; ++k) { p2[k] = 0.f; p1[k] = 0.f; }
                } else {
#pragma unroll
                    for (int hh = 0; hh < 2; ++hh) {
                        const v4u a = *(const v4u*)(HALO + ((size_t)(seg - 1) * 2 + 0) * FF2 + c + hh * DFF), b_ = *(const v4u*)(HALO + ((size_t)(seg - 1) * 2 + 1) * FF2 + c + hh * DFF);
                        p2[hh * 8 + 0] = bflo(a.x); p2[hh * 8 + 1] = bfhi(a.x); p2[hh * 8 + 2] = bflo(a.y); p2[hh * 8 + 3] = bfhi(a.y);
                        p2[hh * 8 + 4] = bflo(a.z); p2[hh * 8 + 5] = bfhi(a.z); p2[hh * 8 + 6] = bflo(a.w); p2[hh * 8 + 7] = bfhi(a.w);
                        p1[hh * 8 + 0] = bflo(b_.x); p1[hh * 8 + 1] = bfhi(b_.x); p1[hh * 8 + 2] = bflo(b_.y); p1[hh * 8 + 3] = bfhi(b_.y);
                        p1[hh * 8 + 4] = bflo(b_.z); p1[hh * 8 + 5] = bfhi(b_.z); p1[hh * 8 + 6] = bflo(b_.w); p1[hh * 8 + 7] = bfhi(b_.w);
                    }
                }
            }
#pragma unroll 2
            for (int i = 0; i < 32; ++i) {
                const int r = r0 + i;
                if (!prompt && (i & 15) == 0) {
                    const float* sc = state_conv + (size_t)((r - MP) >> 4) * 2 * FF2;
#pragma unroll
                    for (int hh = 0; hh < 2; ++hh)
#pragma unroll
                        for (int e = 0; e < 8; e += 4) {
                            const f32x4 a = *(const f32x4*)(sc + c + hh * DFF + e), b_ = *(const f32x4*)(sc + FF2 + c + hh * DFF + e);
#pragma unroll
                            for (int k = 0; k < 4; ++k) { p2[hh * 8 + e + k] = a[k]; p1[hh * 8 + e + k] = b_[k]; }
                        }
                }
                bf16* rowp = UP + (size_t)r * FF2 + c;
                const v4u gv = *(const v4u*)rowp, vv = *(const v4u*)(rowp + DFF);
                float cur[16];
                cur[0] = bflo(gv.x); cur[1] = bfhi(gv.x); cur[2] = bflo(gv.y); cur[3] = bfhi(gv.y); cur[4] = bflo(gv.z); cur[5] = bfhi(gv.z); cur[6] = bflo(gv.w); cur[7] = bfhi(gv.w);
                cur[8] = bflo(vv.x); cur[9] = bfhi(vv.x); cur[10] = bflo(vv.y); cur[11] = bfhi(vv.y); cur[12] = bflo(vv.z); cur[13] = bfhi(vv.z); cur[14] = bflo(vv.w); cur[15] = bfhi(vv.w);
                float act[8];
#pragma unroll
                for (int k = 0; k < 8; ++k) {
                    const float gt_ = cb[k] + w0[k] * p2[k] + w1[k] * p1[k] + w2[k] * cur[k];
                    const float vl = cb[8 + k] + w0[8 + k] * p2[8 + k] + w1[8 + k] * p1[8 + k] + w2[8 + k] * cur[8 + k];
                    const float inner = gt_ * (1.0f + 0.044715f * gt_ * gt_);
                    const float sg = __builtin_amdgcn_rcpf(1.0f + __builtin_amdgcn_exp2f(-2.0f * 0.7978845608028654f * 1.4426950408889634f * inner));
                    act[k] = gt_ * sg * vl;
                }
#pragma unroll
                for (int k = 0; k < 16; ++k) { p2[k] = p1[k]; p1[k] = cur[k]; }
                v4u o; o.x = pk2(act[0], act[1]); o.y = pk2(act[2], act[3]); o.z = pk2(act[4], act[5]); o.w = pk2(act[6], act[7]);
                *(v4u*)rowp = o;
            }
        }
    }
    xcd_barrier(bar); STAMP();

    {
        pg8::Gemm g{UP, WDN, M, D_MODEL, DFF, FF2}; pg8::StaticOrder S; S.init(M, D_MODEL, G, bx);
        pg8::EpiRes2 E{X1};
        pg8::gemm_phase<pg8::EpiRes2, pg8::StaticOrder, true>(lds, g, S, E);
    }
    xcd_barrier(bar); STAMP();

    for (int m = gw; m < M; m += NGW) {
        GAS f32x4* xv = (GAS f32x4*)(X1 + (size_t)m * D_MODEL) + lane;
        f32x4 v[4]; float s = 0.f;
#pragma unroll
        for (int j = 0; j < 4; ++j) { v[j] = xv[64 * j]; s += (v[j].x * v[j].x + v[j].y * v[j].y) + (v[j].z * v[j].z + v[j].w * v[j].w); }
#pragma unroll
        for (int o = 1; o < 64; o <<= 1) s += __shfl_xor(s, o);
        const float rs = 1.0f / sqrtf(s * (1.0f / D_MODEL) + EPS);
#pragma unroll
        for (int j = 0; j < 4; ++j) { const f32x4 gv = *((const f32x4*)norm_final + lane + 64 * j); xv[64 * j] = v[j] * rs * gv; }
    }
    if (PROBE_MASK) { STAMP(); if (bx == 0 && tid == 0) { const unsigned long long t0_ = __builtin_amdgcn_s_memrealtime(); while (__builtin_amdgcn_s_memrealtime() - t0_ < ts_acc * PROBE_MULT) __builtin_amdgcn_s_sleep(8); } }
}

extern "C" void kernel_launch(void* const* d_in, const int* in_sizes, int n_in, void* d_out, int out_size, void* d_ws, size_t ws_size, hipStream_t stream) {
    static int grid = 0;
    if (grid == 0) {
        if (n_in != 19 || (size_t)out_size != O_END || ws_size < WS_END) {
            fprintf(stderr, "kernel_launch: unexpected sizes n_in %d out %d ws %zu (need %zu)\n", n_in, out_size, ws_size, (size_t)WS_END); grid = -1; return; }
        int dev = 0, cus = 0, per_cu = 0;
        if (hipGetDevice(&dev) != hipSuccess || hipDeviceGetAttribute(&cus, hipDeviceAttributeMultiprocessorCount, dev) != hipSuccess) { grid = -1; return; }
        if (hipFuncSetAttribute((const void*)fwd_mega, hipFuncAttributeMaxDynamicSharedMemorySize, LDS_BYTES) != hipSuccess) { fprintf(stderr, "kernel_launch: hipFuncSetAttribute failed\n"); grid = -1; return; }
        if (hipOccupancyMaxActiveBlocksPerMultiprocessor(&per_cu, (const void*)fwd_mega, NWAVES * 64, LDS_BYTES) != hipSuccess || per_cu < 1)
            fprintf(stderr, "kernel_launch: occupancy query reports %d blocks per CU\n", per_cu);
        (void)hipGetLastError();
        grid = cus;
    }
    if (grid < 0) return;
    (void)hipMemsetAsync((char*)d_ws + WS_CTL, 0, CTL_ZERO_BYTES, stream);
    Args a{};
    for (int i = 0; i < 19; ++i) a.in[i] = (const float*)d_in[i];
    a.out = (float*)d_out; a.ws = (unsigned char*)d_ws;
    hipLaunchKernelGGL(fwd_mega, dim3(grid), dim3(NWAVES * 64), LDS_BYTES, stream, a);
}
```

```cpp
#include <hip/hip_runtime.h>
#include <hip/hip_bf16.h>
#include <cstdio>
#include <cstdint>

constexpr int D_MODEL = 1024, BATCH = 16, SEQ = 2048, DEC_BATCH = 32, DEC_SEQ = 16, PAST = 1024;
constexpr int NH = 8, HD = 64, AW = 512, PW = 512, PG = 128, PSTATE = 15, DFF = 2816, FF2 = 5632, INW = 4096;
constexpr int MP = BATCH * SEQ, MS = DEC_BATCH * DEC_SEQ, M = MP + MS;
constexpr float EPS = 1e-6f;
constexpr float C2 = 0.125f * 1.4426950408889634f;

constexpr size_t O_YP = 0;
constexpr size_t O_YS = O_YP + (size_t)MP * D_MODEL;
constexpr size_t O_KP = O_YS + (size_t)MS * D_MODEL;
constexpr size_t O_VP = O_KP + (size_t)MP * AW;
constexpr size_t O_PP = O_VP + (size_t)MP * AW;
constexpr size_t O_CP = O_PP + (size_t)BATCH * PSTATE * PW;
constexpr size_t O_KS = O_CP + (size_t)BATCH * 2 * FF2;
constexpr size_t O_VS = O_KS + (size_t)MS * AW;
constexpr size_t O_PS = O_VS + (size_t)MS * AW;
constexpr size_t O_CS = O_PS + (size_t)DEC_BATCH * PSTATE * PW;
constexpr size_t O_END = O_CS + (size_t)DEC_BATCH * 2 * FF2;

namespace pg8 {
#define PG8_LAS __attribute__((address_space(3)))
typedef unsigned short bf16_t;
typedef short bf16x8 __attribute__((ext_vector_type(8)));
typedef float f32x4 __attribute__((ext_vector_type(4)));
typedef unsigned u32x4 __attribute__((ext_vector_type(4)));
constexpr int BM = 256, BK = 64, HALF = 128, HTB = HALF * BK * 2, STAGE_BYTES = 8 * HTB, NXCD = 8, WGM = 8;

__host__ __device__ __forceinline__ int lds_byte(int r, int c) { const int st = (r >> 4) * 2 + (c >> 5), rr = r & 15, cc = c & 31, ob = rr * 64 + cc * 2; return st * 1024 + (ob ^ (((ob >> 9) & 1) << 5)); }
__host__ __device__ __forceinline__ void stage_rc(int b, int& R, int& C) { const int st = b / 1024, sb = b % 1024, swz = sb ^ (((sb >> 9) & 1) << 5); R = (st >> 1) * 16 + swz / 64; C = (st & 1) * 32 + (swz % 64) / 2; }
__host__ __device__ __forceinline__ int perm32(int rho) { const int n = rho >> 4, i = rho & 15; return 8 * (i >> 2) + 4 * n + (i & 3); }

struct Unit { int pm, pn; };
struct Gemm { const bf16_t* A; const bf16_t* Bt; int M, N, K, lda; };

struct StaticOrder {
    int nM, nN, nwg, G, c;
    __host__ __device__ void init(int M_, int N_, int G_, int c_) { nM = M_ / BM; nN = N_ / BM; nwg = nM * nN; G = G_; c = c_; }
    __host__ __device__ bool next(int i, Unit& u) const {
        const long L = (long)i * G + c; if (L >= nwg) return false;
        int wgid = (int)L; { const int q = nwg / NXCD, r = nwg % NXCD, xcd = wgid % NXCD, off = wgid / NXCD; wgid = (xcd < r ? xcd * (q + 1) : r * (q + 1) + (xcd - r) * q) + off; }
        const int nig = WGM * nN, gid = wgid / nig, fm = gid * WGM, gsz = (nM - fm) < WGM ? (nM - fm) : WGM;
        u.pm = fm + ((wgid % nig) % gsz); u.pn = (wgid % nig) / gsz; return true;
    }
};

__device__ __forceinline__ unsigned cvt_pk_bf16(float lo, float hi) { unsigned r; asm volatile("v_cvt_pk_bf16_f32 %0, %1, %2" : "=v"(r) : "v"(lo), "v"(hi)); return r; }
__device__ __forceinline__ float bf_lo(unsigned u) { return __uint_as_float(u << 16); }
__device__ __forceinline__ float bf_hi(unsigned u) { return __uint_as_float(u & 0xffff0000u); }

template <class Epi, class Sched, bool ALIGN_EPI>
__device__ __forceinline__ void gemm_phase(PG8_LAS unsigned char* lds, const Gemm g, const Sched& S, const Epi& E) {
    int tid = threadIdx.x; asm volatile("" : "+v"(tid));
    const int wid = __builtin_amdgcn_readfirstlane(tid >> 6), lane = tid & 63, wr = wid >> 2, wc = wid & 3, fr = lane & 15, fq = lane >> 4;
    const int K = g.K, nt = K / BK, lda = g.lda;
    unsigned voffA[2], voffB[2];
#pragma unroll
    for (int i = 0; i < 2; ++i) { int R, C; stage_rc(tid * 16 + i * 8192, R, C); const int Rb = Epi::PERM ? ((R & ~31) + perm32(R & 31)) : R;
        voffA[i] = (unsigned)(R * lda + C) * 2u; voffB[i] = (unsigned)(Rb * K + C) * 2u; }
    const size_t kstep = (size_t)(BK * 2);
    const size_t hstepA = (size_t)HALF * lda * 2, hstepB = (size_t)HALF * K * 2;
    const size_t tstepA = 2 * hstepA, tstepB = 2 * hstepB;
    const unsigned ldsw = (unsigned)wid * 1024u;
    const int aoff = lds_byte(wr * 64 + fr, fq * 8), boff = lds_byte(wc * 32 + fr, fq * 8);
#define PG8_SA(b, h) (((b) * 2 + (h)) * HTB)
#define PG8_SB(b, h) ((4 + (b) * 2 + (h)) * HTB)
#define PG8_STAGE(bufoff, gbase, voff) do { _Pragma("unroll") for (int _i = 0; _i < 2; ++_i) \
        __builtin_amdgcn_global_load_lds((const unsigned*)((const char*)(gbase) + (voff)[_i]), (PG8_LAS unsigned*)(lds + (bufoff) + ldsw + _i * 8192), 16, 0, 0); } while (0)
#define PG8_LDA(dst, b, h) do { _Pragma("unroll") for (int m = 0; m < 4; ++m) _Pragma("unroll") for (int k = 0; k < 2; ++k) dst[m][k] = *(const PG8_LAS bf16x8*)(lds + PG8_SA(b, h) + aoff + m * 2048 + k * 1024); } while (0)
#define PG8_LDB(dst, b, h) do { _Pragma("unroll") for (int n = 0; n < 2; ++n) _Pragma("unroll") for (int k = 0; k < 2; ++k) dst[n][k] = *(const PG8_LAS bf16x8*)(lds + PG8_SB(b, h) + boff + n * 2048 + k * 1024); } while (0)
#define PG8_MMA(ai, bj, At, Bt) do { __builtin_amdgcn_s_setprio(1); _Pragma("unroll") for (int m = 0; m < 4; ++m) _Pragma("unroll") for (int n = 0; n < 2; ++n) _Pragma("unroll") for (int k = 0; k < 2; ++k) \
        acc[ai][bj][m][n] = __builtin_amdgcn_mfma_f32_16x16x32_bf16(Bt[n][k], At[m][k], acc[ai][bj][m][n], 0, 0, 0); __builtin_amdgcn_s_setprio(0); } while (0)
#define PG8_WAIT_V(n) asm volatile("s_waitcnt vmcnt(" #n ")" ::: "memory")
#define PG8_WAIT_L(n) asm volatile("s_waitcnt lgkmcnt(" #n ")" ::: "memory")
#define PG8_BAR __builtin_amdgcn_s_barrier()
#define PG8_SCHED __builtin_amdgcn_sched_barrier(0)
    Unit cur, nxt; int ui = 0;
    if (!S.next(0, cur)) return;
    f32x4 acc[2][2][4][2];
#pragma unroll
    for (int a = 0; a < 2; ++a)
#pragma unroll
        for (int b = 0; b < 2; ++b)
#pragma unroll
            for (int m = 0; m < 4; ++m)
#pragma unroll
                for (int n = 0; n < 2; ++n) acc[a][b][m][n] = (f32x4){0.f, 0.f, 0.f, 0.f};
    bf16x8 At[4][2], B0[2][2], B1[2][2];
    const char* cA = (const char*)g.A + (size_t)cur.pm * tstepA; const char* cB = (const char*)g.Bt + (size_t)cur.pn * tstepB;
    PG8_STAGE(PG8_SB(0, 0), cB, voffB); PG8_STAGE(PG8_SB(0, 1), cB + hstepB, voffB); PG8_STAGE(PG8_SA(0, 0), cA, voffA); PG8_STAGE(PG8_SA(0, 1), cA + hstepA, voffA);
    if (wr == 1) PG8_BAR;
    PG8_WAIT_V(2); PG8_BAR;
    PG8_STAGE(PG8_SB(1, 0), cB + kstep, voffB); PG8_STAGE(PG8_SA(1, 0), cA + kstep, voffA); PG8_STAGE(PG8_SB(1, 1), cB + hstepB + kstep, voffB);
    PG8_WAIT_V(6); PG8_BAR;
    for (;;) {
        const bool has_next = S.next(ui + 1, nxt);
        const char* nA = has_next ? (const char*)g.A + (size_t)nxt.pm * tstepA : cA; const char* nB = has_next ? (const char*)g.Bt + (size_t)nxt.pn * tstepB : cB;
        for (int t = 0; t < nt; t += 2) {
            const bool last = (t == nt - 2);
            const char* a1 = cA + (size_t)(t + 1) * kstep;
            const char* a2 = last ? nA : cA + (size_t)(t + 2) * kstep; const char* b2 = last ? nB : cB + (size_t)(t + 2) * kstep;
            const char* a3 = a2 + kstep; const char* b3 = b2 + kstep;
            PG8_LDB(B0, 0, 0); PG8_LDB(B1, 0, 1); PG8_SCHED; PG8_LDA(At, 0, 0); PG8_STAGE(PG8_SA(1, 1), a1 + hstepA, voffA);
            PG8_WAIT_V(8); PG8_WAIT_L(0); PG8_BAR; PG8_MMA(0, 0, At, B0); PG8_MMA(0, 1, At, B1); PG8_BAR; PG8_SCHED;
            PG8_LDA(At, 0, 1); PG8_STAGE(PG8_SB(0, 0), b2, voffB); PG8_STAGE(PG8_SB(0, 1), b2 + hstepB, voffB); PG8_STAGE(PG8_SA(0, 0), a2, voffA);
            PG8_WAIT_V(8); PG8_WAIT_L(0); PG8_BAR; PG8_MMA(1, 0, At, B0); PG8_MMA(1, 1, At, B1); PG8_BAR; PG8_SCHED;
            PG8_LDB(B0, 1, 0); PG8_LDB(B1, 1, 1); PG8_SCHED; PG8_LDA(At, 1, 0); PG8_STAGE(PG8_SA(0, 1), a2 + hstepA, voffA);
            PG8_WAIT_V(8); PG8_WAIT_L(0); PG8_BAR; PG8_MMA(0, 0, At, B0); PG8_MMA(0, 1, At, B1); PG8_BAR; PG8_SCHED;
            PG8_LDA(At, 1, 1); PG8_STAGE(PG8_SB(1, 0), b3, voffB); PG8_STAGE(PG8_SB(1, 1), b3 + hstepB, voffB); PG8_STAGE(PG8_SA(1, 0), a3, voffA);
            PG8_WAIT_V(8); PG8_WAIT_L(0); PG8_BAR; PG8_MMA(1, 0, At, B0); PG8_MMA(1, 1, At, B1); PG8_BAR; PG8_SCHED;
        }
        if constexpr (ALIGN_EPI) { if (wr == 0) PG8_BAR; }
        E(acc, cur, wr, wc, fr, fq);
        if (!has_next) break;
#pragma unroll
        for (int a = 0; a < 2; ++a)
#pragma unroll
            for (int b = 0; b < 2; ++b)
#pragma unroll
                for (int m = 0; m < 4; ++m)
#pragma unroll
                    for (int n = 0; n < 2; ++n) acc[a][b][m][n] = (f32x4){0.f, 0.f, 0.f, 0.f};
        cur = nxt; cA = nA; cB = nB; ++ui;
        if constexpr (ALIGN_EPI) { if (wr == 1) PG8_BAR; }
    }
    PG8_WAIT_V(0);
    if constexpr (!ALIGN_EPI) { if (wr == 0) PG8_BAR; }
    PG8_BAR;
#undef PG8_SA
#undef PG8_SB
#undef PG8_STAGE
#undef PG8_LDA
#undef PG8_LDB
#undef PG8_MMA
#undef PG8_WAIT_V
#undef PG8_WAIT_L
#undef PG8_BAR
#undef PG8_SCHED
}

__device__ __forceinline__ float sigmoid_fast(float x) { return __builtin_amdgcn_rcpf(1.0f + __builtin_amdgcn_exp2f(-1.4426950408889634f * x)); }

struct EpiIn {
    static constexpr bool PERM = true;
    const float* rstd; bf16_t* QB; bf16_t* KB; bf16_t* VB; float* UB; bf16_t* SG; float* out;
    __device__ __forceinline__ void operator()(const f32x4 (&acc)[2][2][4][2], const Unit& u, int wr, int wc, int fr, int fq) const {
        const int pn = u.pn, pm = u.pm;
        bf16_t* db = nullptr; float* df = nullptr; int ldb = 0, ldf = 0, cbase = 0; float mult = 1.f; bool sig = false;
        if (pn < 2) { db = QB; ldb = AW; cbase = 0; mult = C2; }
        else if (pn < 4) { db = KB; ldb = AW; cbase = 512; df = (pm < MP / 256) ? out + O_KP : out + O_KS - (size_t)MP * AW; ldf = AW; }
        else if (pn < 6) { db = VB; ldb = AW; cbase = 1024; df = (pm < MP / 256) ? out + O_VP : out + O_VS - (size_t)MP * AW; ldf = AW; }
        else if (pn < 8) { df = UB; ldf = PW; cbase = 1536; }
        else { db = SG; ldb = 2048; cbase = 2048; sig = true; }
        const int row0 = pm * BM + wr * 64 + fr;
        const int col0 = pn * BM + wc * 32 + 8 * fq - cbase;
#pragma unroll
        for (int ai = 0; ai < 2; ++ai)
#pragma unroll
            for (int m = 0; m < 4; ++m) {
                const int row = row0 + ai * HALF + m * 16;
                const float rs = rstd[row] * mult;
#pragma unroll
                for (int bj = 0; bj < 2; ++bj) {
                    f32x4 v0 = acc[ai][bj][m][0] * rs, v1 = acc[ai][bj][m][1] * rs;
                    const int col = col0 + bj * HALF;
                    if (sig) {
#pragma unroll
                        for (int e = 0; e < 4; ++e) { v0[e] = sigmoid_fast(v0[e]); v1[e] = sigmoid_fast(v1[e]); }
                    }
                    if (db) { u32x4 w; w.x = cvt_pk_bf16(v0[0], v0[1]); w.y = cvt_pk_bf16(v0[2], v0[3]); w.z = cvt_pk_bf16(v1[0], v1[1]); w.w = cvt_pk_bf16(v1[2], v1[3]);
                        *(u32x4*)(db + (size_t)row * ldb + col) = w; }
                    if (df) { float* p = df + (size_t)row * ldf + col; *(f32x4*)p = v0; *(f32x4*)(p + 4) = v1; }
                }
            }
    }
};

template <bool ACCUM> struct EpiGate {
    static constexpr bool PERM = true;
    bf16_t* MG; const bf16_t* SG; int goff;
    __device__ __forceinline__ void operator()(const f32x4 (&acc)[2][2][4][2], const Unit& u, int wr, int wc, int fr, int fq) const {
        const int row0 = u.pm * BM + wr * 64 + fr, col0 = u.pn * BM + wc * 32 + 8 * fq;
#pragma unroll
        for (int ai = 0; ai < 2; ++ai)
#pragma unroll
            for (int m = 0; m < 4; ++m) {
                const int row = row0 + ai * HALF + m * 16;
#pragma unroll
                for (int bj = 0; bj < 2; ++bj) {
                    const int col = col0 + bj * HALF;
                    const u32x4 gv = *(const u32x4*)(SG + (size_t)row * 2048 + goff + col);
                    f32x4 v0 = acc[ai][bj][m][0], v1 = acc[ai][bj][m][1];
                    v0[0] *= bf_lo(gv.x); v0[1] *= bf_hi(gv.x); v0[2] *= bf_lo(gv.y); v0[3] *= bf_hi(gv.y);
                    v1[0] *= bf_lo(gv.z); v1[1] *= bf_hi(gv.z); v1[2] *= bf_lo(gv.w); v1[3] *= bf_hi(gv.w);
                    bf16_t* dp = MG + (size_t)row * D_MODEL + col;
                    if (ACCUM) { const u32x4 ov = *(const u32x4*)dp;
                        v0[0] += bf_lo(ov.x); v0[1] += bf_hi(ov.x); v0[2] += bf_lo(ov.y); v0[3] += bf_hi(ov.y);
                        v1[0] += bf_lo(ov.z); v1[1] += bf_hi(ov.z); v1[2] += bf_lo(ov.w); v1[3] += bf_hi(ov.w); }
                    u32x4 w; w.x = cvt_pk_bf16(v0[0], v0[1]); w.y = cvt_pk_bf16(v0[2], v0[3]); w.z = cvt_pk_bf16(v1[0], v1[1]); w.w = cvt_pk_bf16(v1[2], v1[3]);
                    *(u32x4*)dp = w;
                }
            }
    }
};

struct EpiRes1 {
    static constexpr bool PERM = true;
    const float* xp; const float* xs; float* X1; bf16_t* X1B; float* SSQ;
    __device__ __forceinline__ void operator()(const f32x4 (&acc)[2][2][4][2], const Unit& u, int wr, int wc, int fr, int fq) const {
        const int row0 = u.pm * BM + wr * 64 + fr, col0 = u.pn * BM + wc * 32 + 8 * fq;
        const float* xsrc = (u.pm < MP / 256) ? xp : xs - (size_t)MP * D_MODEL;
#pragma unroll
        for (int ai = 0; ai < 2; ++ai)
#pragma unroll
            for (int m = 0; m < 4; ++m) {
                const int row = row0 + ai * HALF + m * 16; float s = 0.f;
#pragma unroll
                for (int bj = 0; bj < 2; ++bj) {
                    const size_t off = (size_t)row * D_MODEL + col0 + bj * HALF;
                    const f32x4 x0 = *(const f32x4*)(xsrc + off), x1 = *(const f32x4*)(xsrc + off + 4);
                    const f32x4 v0 = acc[ai][bj][m][0] + x0, v1 = acc[ai][bj][m][1] + x1;
                    s += (v0[0] * v0[0] + v0[1] * v0[1]) + (v0[2] * v0[2] + v0[3] * v0[3]) + (v1[0] * v1[0] + v1[1] * v1[1]) + (v1[2] * v1[2] + v1[3] * v1[3]);
                    *(f32x4*)(X1 + off) = v0; *(f32x4*)(X1 + off + 4) = v1;
                    u32x4 w; w.x = cvt_pk_bf16(v0[0], v0[1]); w.y = cvt_pk_bf16(v0[2], v0[3]); w.z = cvt_pk_bf16(v1[0], v1[1]); w.w = cvt_pk_bf16(v1[2], v1[3]);
                    *(u32x4*)(X1B + off) = w;
                }
                s += __shfl_xor(s, 16); s += __shfl_xor(s, 32);
                if (fq == 0) SSQ[(size_t)row * 16 + u.pn * 4 + wc] = s;
            }
    }
};

struct EpiUp {
    static constexpr bool PERM = true;
    const float* SSQ; bf16_t* UP; bf16_t* HALO; float* out;
    __device__ __forceinline__ void operator()(const f32x4 (&acc)[2][2][4][2], const Unit& u, int wr, int wc, int fr, int fq) const {
        const int row0 = u.pm * BM + wr * 64 + fr, col0 = u.pn * BM + wc * 32 + 8 * fq;
        const bool prompt = u.pm < MP / 256;
#pragma unroll
        for (int ai = 0; ai < 2; ++ai)
#pragma unroll
            for (int m = 0; m < 4; ++m) {
                const int row = row0 + ai * HALF + m * 16;
                const f32x4* sp = (const f32x4*)(SSQ + (size_t)row * 16);
                const f32x4 s0 = sp[0], s1 = sp[1], s2 = sp[2], s3 = sp[3];
                const float ss = ((s0[0] + s0[1]) + (s0[2] + s0[3])) + ((s1[0] + s1[1]) + (s1[2] + s1[3])) + ((s2[0] + s2[1]) + (s2[2] + s2[3])) + ((s3[0] + s3[1]) + (s3[2] + s3[3]));
                const float rs = __builtin_amdgcn_rsqf(ss * (1.0f / D_MODEL) + EPS);
                const bool halo = (row & 31) >= 30;
                float* cdst = nullptr;
                if (prompt) { if ((row & (SEQ - 1)) >= SEQ - 2) cdst = out + O_CP + ((size_t)(row >> 11) * 2 + ((row & (SEQ - 1)) - (SEQ - 2))) * FF2; }
                else { if ((row & 15) >= 14) cdst = out + O_CS + ((size_t)((row - MP) >> 4) * 2 + ((row & 15) - 14)) * FF2; }
#pragma unroll
                for (int bj = 0; bj < 2; ++bj) {
                    const int col = col0 + bj * HALF;
                    const f32x4 v0 = acc[ai][bj][m][0] * rs, v1 = acc[ai][bj][m][1] * rs;
                    u32x4 w; w.x = cvt_pk_bf16(v0[0], v0[1]); w.y = cvt_pk_bf16(v0[2], v0[3]); w.z = cvt_pk_bf16(v1[0], v1[1]); w.w = cvt_pk_bf16(v1[2], v1[3]);
                    *(u32x4*)(UP + (size_t)row * FF2 + col) = w;
                    if (halo) *(u32x4*)(HALO + ((size_t)(row >> 5) * 2 + ((row & 31) - 30)) * FF2 + col) = w;
                    if (cdst) { *(f32x4*)(cdst + col) = v0; *(f32x4*)(cdst + col + 4) = v1; }
                }
            }
    }
};

struct EpiRes2 {
    static constexpr bool PERM = true;
    float* X;
    __device__ __forceinline__ void operator()(const f32x4 (&acc)[2][2][4][2], const Unit& u, int wr, int wc, int fr, int fq) const {
        const int row0 = u.pm * BM + wr * 64 + fr, col0 = u.pn * BM + wc * 32 + 8 * fq;
#pragma unroll
        for (int ai = 0; ai < 2; ++ai)
#pragma unroll
            for (int m = 0; m < 4; ++m) {
                const int row = row0 + ai * HALF + m * 16;
#pragma unroll
                for (int bj = 0; bj < 2; ++bj) {
                    float* p = X + (size_t)row * D_MODEL + col0 + bj * HALF;
                    const f32x4 x0 = *(const f32x4*)p, x1 = *(const f32x4*)(p + 4);
                    *(f32x4*)p = acc[ai][bj][m][0] + x0; *(f32x4*)(p + 4) = acc[ai][bj][m][1] + x1;
                }
            }
    }
};
}

#define GAS __attribute__((address_space(1)))
#define LAS __attribute__((address_space(3)))
typedef unsigned short bf16;
typedef unsigned v4u __attribute__((ext_vector_type(4)));
typedef unsigned v2u __attribute__((ext_vector_type(2)));
typedef float f32x4 __attribute__((ext_vector_type(4)));
typedef float f32x16 __attribute__((ext_vector_type(16)));
typedef short bf16x8 __attribute__((ext_vector_type(8)));
typedef short v4i16_t __attribute__((ext_vector_type(4)));
typedef GAS unsigned gu32;
#define RLX_AGENT __ATOMIC_RELAXED, __HIP_MEMORY_SCOPE_AGENT
#define LDS_WAIT() asm volatile("s_waitcnt lgkmcnt(0)" ::: "memory")
#define VM_WAIT() asm volatile("s_waitcnt vmcnt(0)" ::: "memory")
__device__ __forceinline__ unsigned f2bf(float f) { unsigned u = __builtin_bit_cast(unsigned, f); return (u + 0x7fffu + ((u >> 16) & 1u)) >> 16; }
__device__ __forceinline__ unsigned pk2(float lo, float hi) { return f2bf(lo) | (f2bf(hi) << 16); }
__device__ __forceinline__ float bflo(unsigned u) { return __uint_as_float(u << 16); }
__device__ __forceinline__ float bfhi(unsigned u) { return __uint_as_float(u & 0xffff0000u); }

#define XB_TMO      128
#define XB_XCNT(j)  (256  + 64 * (j))
#define XB_XSUB(j)  (1280 + 64 * (j))
#define XB_XGEN(j)  (2304 + 64 * (j))
#define XB_TOP      3328
#define XB_TOPGEN   3392
#define XCD_BAR_WORDS 3456
#define XB_SPIN_CAP (1u << 18)

__device__ __forceinline__ unsigned xb_ld(unsigned* p)              { return __hip_atomic_load(p, __ATOMIC_RELAXED, __HIP_MEMORY_SCOPE_AGENT); }
__device__ __forceinline__ unsigned xb_add(unsigned* p, unsigned v) { return __hip_atomic_fetch_add(p, v, __ATOMIC_RELAXED, __HIP_MEMORY_SCOPE_AGENT); }
__device__ __forceinline__ unsigned xb_xcc_id() { return (unsigned)__builtin_amdgcn_s_getreg((3 << 11) | 20) & 0xFu; }
#define XB_SPIN(cond, bar) do { unsigned _sp = 0; while (cond) { __builtin_amdgcn_s_sleep(1); \
    if ((++_sp & 255u) == 0u) { if (xb_ld(&(bar)[XB_TMO])) break; if (_sp > XB_SPIN_CAP) { atomicAdd(&(bar)[XB_TMO], 1u); break; } } } } while (0)

struct XcdBarrier { unsigned* bar; unsigned x; volatile LAS unsigned* st; };

__device__ __forceinline__ XcdBarrier xcd_barrier_post(unsigned* bar, volatile LAS unsigned* st) {
    XcdBarrier b; b.bar = bar; b.x = xb_xcc_id(); b.st = st;
    if (threadIdx.x == 0) (void)xb_add(&bar[XB_XCNT(b.x)], 1u);
    return b;
}
__device__ __forceinline__ void xcd_barrier_complete(unsigned* bar, unsigned x, unsigned& nloc, unsigned& nx) {
    const unsigned G = gridDim.x * gridDim.y * gridDim.z;
    unsigned sum, cnt, mine, sp = 0u;
    for (;;) {
        sum = 0u; cnt = 0u; mine = 0u;
#pragma unroll
        for (unsigned j = 0; j < 16; ++j) { const unsigned c = xb_ld(&bar[XB_XCNT(j)]); sum += c; cnt += (c > 0u) ? 1u : 0u; mine = (j == x) ? c : mine; }
        if (sum == G) break;
        __builtin_amdgcn_s_sleep(1);
        if ((++sp & 255u) == 0u) { if (xb_ld(&bar[XB_TMO])) break; if (sp > XB_SPIN_CAP) { atomicAdd(&bar[XB_TMO], 1u); break; } }
    }
    nloc = mine > 0u ? mine : 1u; nx = cnt > 0u ? cnt : 1u;
}
__device__ __forceinline__ void xcd_barrier(const XcdBarrier& b) {
    asm volatile("s_waitcnt vmcnt(0)" ::: "memory");
    __syncthreads();
    if (threadIdx.x == 0) {
        unsigned* bar = b.bar;
        __builtin_amdgcn_s_waitcnt(0);
        unsigned nloc = b.st[0], nx = b.st[1];
        if (nloc == 0u) { xcd_barrier_complete(bar, b.x, nloc, nx); b.st[0] = nloc; b.st[1] = nx; }
        const unsigned old = xb_add(&bar[XB_XSUB(b.x)], 1u);
        const unsigned gen = old / nloc;
        if (old + 1u == (gen + 1u) * nloc) {
            __builtin_amdgcn_fence(__ATOMIC_RELEASE, "agent");
            asm volatile("s_waitcnt vmcnt(0)" ::: "memory");
            const unsigned og = xb_add(&bar[XB_TOP], 1u);
            const unsigned tg = og / nx;
            if (og + 1u == (tg + 1u) * nx) xb_add(&bar[XB_TOPGEN], 1u);
            else XB_SPIN(xb_ld(&bar[XB_TOPGEN]) == tg, bar);
            __builtin_amdgcn_fence(__ATOMIC_ACQUIRE, "agent");
            xb_add(&bar[XB_XGEN(b.x)], 1u);
            asm volatile("s_waitcnt vmcnt(0)" ::: "memory");
        } else {
            XB_SPIN(xb_ld(&bar[XB_XGEN(b.x)]) == gen, bar);
            __builtin_amdgcn_fence(__ATOMIC_ACQUIRE, "agent");
            asm volatile("s_waitcnt vmcnt(0)" ::: "memory");
        }
    }
    __syncthreads();
}

constexpr size_t MiB = 1u << 20;
constexpr size_t WS_CTL = 0, CTL_ZERO_BYTES = 1 * MiB;
constexpr size_t WS_WIN = 2 * MiB;
constexpr size_t WS_WA = 10 * MiB;
constexpr size_t WS_WPB = 11 * MiB;
constexpr size_t WS_WO = 12 * MiB;
constexpr size_t WS_WUP = 14 * MiB;
constexpr size_t WS_WDN = 25 * MiB;
constexpr size_t WS_RSTD1 = 31 * MiB;
constexpr size_t WS_SSQ = 32 * MiB;
constexpr size_t WS_HALO = 35 * MiB;
constexpr size_t WS_X1B = 58 * MiB;
constexpr size_t WS_RA = 123 * MiB;
constexpr size_t RA_XB = WS_RA;
constexpr size_t RA_QB = WS_RA + (size_t)M * 1024 * 2;
constexpr size_t RA_KB = RA_QB + (size_t)M * 512 * 2;
constexpr size_t RA_VB = RA_KB + (size_t)M * 512 * 2;
constexpr size_t RA_UB = RA_VB + (size_t)M * 512 * 2;
constexpr size_t RA_SG = RA_UB + (size_t)M * 512 * 4;
constexpr size_t RA_END = RA_SG + (size_t)M * 2048 * 2;
constexpr size_t RA_UP = WS_RA;
static_assert(RA_UP + (size_t)M * FF2 * 2 <= RA_END, "UP fits region A");
constexpr size_t WS_END = RA_END;
static_assert(WS_HALO + (size_t)(M / 32) * 2 * FF2 * 2 <= WS_X1B && WS_X1B + (size_t)M * 1024 * 2 <= WS_RA && WS_SSQ + (size_t)M * 64 <= WS_HALO, "ws map");
constexpr int CW_BAR = 4096;

constexpr int RING_BYTES = 131072;
constexpr int LDSCTL_OFF = RING_BYTES, MISC_OFF = LDSCTL_OFF + 320;
constexpr int LDS_BYTES = 147456;
constexpr int NWAVES = 8;

struct Args {
    const float* in[19]; float* out; unsigned char* ws;
};
#ifndef PROBE_MASK
#define PROBE_MASK 0
#endif
#ifndef PROBE_MULT
#define PROBE_MULT 4
#endif

__device__ __forceinline__ void p0_transpose_item(const float* W, const float* gk, int K, int N, bf16* WT, LAS float* scr, int item, int lane) {
    const int nblk = N / 32, kb = item / nblk, nb = item % nblk, k0 = 64 * kb, n0 = 32 * nb;
#pragma unroll 8
    for (int i = 0; i < 32; ++i) { const int kk = 2 * i + (lane >> 5); float v = W[(size_t)(k0 + kk) * N + n0 + (lane & 31)]; if (gk) v *= gk[k0 + kk]; scr[kk * 33 + (lane & 31)] = v; }
    LDS_WAIT(); asm volatile("" ::: "memory");
    const int c = lane & 7;
#pragma unroll
    for (int j = 0; j < 4; ++j) { const int n = (lane >> 3) + 8 * j; const LAS float* s = scr + (8 * c) * 33 + n;
        v4u o; o.x = pk2(s[0 * 33], s[1 * 33]); o.y = pk2(s[2 * 33], s[3 * 33]); o.z = pk2(s[4 * 33], s[5 * 33]); o.w = pk2(s[6 * 33], s[7 * 33]);
        *(GAS v4u*)(WT + (size_t)(n0 + n) * K + k0 + 8 * c) = o; }
    LDS_WAIT(); asm volatile("" ::: "memory");
}

namespace sb {
__device__ __forceinline__ int pi32(int i) { return 16 * ((i >> 2) & 1) + (i & 3) + 4 * (i >> 3); }
__device__ __forceinline__ unsigned cvtpk(float lo, float hi) { typedef float f2 __attribute__((ext_vector_type(2))); typedef __bf16 b2 __attribute__((ext_vector_type(2))); f2 v = {lo, hi}; b2 b = __builtin_convertvector(v, b2); return __builtin_bit_cast(unsigned, b); }

template <bool MASK>
__device__ __forceinline__ void block(f32x16& p, float& carry, int keybase, int tq, int hi, v4u& pa0, v4u& pa1) {
    float sp[16];
#pragma unroll
    for (int r = 0; r < 16; ++r) {
        float e = __builtin_amdgcn_exp2f(__builtin_amdgcn_fmed3f(p[r], -3.0e38f, 126.0f));
        if (MASK) e = (keybase + r >= tq) ? 0.f : e;
        const float f = __builtin_amdgcn_rcpf(1.0f + e);
        sp[r] = f; p[r] = e * f;
    }
    float run = 1.0f;
#pragma unroll
    for (int r = 15; r >= 0; --r) { const float f = sp[r]; sp[r] = run; run *= f; }
    const float T = -__builtin_amdgcn_logf(run);
    const auto rr = __builtin_amdgcn_permlane32_swap(__float_as_uint(T), __float_as_uint(T), false, false);
    const float other = hi ? __uint_as_float(rr[0]) : __uint_as_float(rr[1]);
    const float F = __builtin_amdgcn_exp2f(-(carry + (hi ? 0.f : other)));
#pragma unroll
    for (int r = 0; r < 16; ++r) p[r] = p[r] * (sp[r] * F);
    carry += T + other;
    pa0 = (v4u){cvtpk(p[0], p[1]), cvtpk(p[2], p[3]), cvtpk(p[4], p[5]), cvtpk(p[6], p[7])};
    pa1 = (v4u){cvtpk(p[8], p[9]), cvtpk(p[10], p[11]), cvtpk(p[12], p[13]), cvtpk(p[14], p[15])};
}

struct AFrag { v4u a10, a11, a00, a01; };
template <bool MASK>
__device__ __forceinline__ void tile_qk(const LAS unsigned char* Kt, const bf16x8 (&qr)[4], float& carry, int k0, int tq, int lane, AFrag& A) {
    const int i = lane & 31, hi = lane >> 5;
    const LAS unsigned char* kp = Kt + hi * 1024; const int kr0 = pi32(i) + 2 * hi;
    {
        f32x16 p1 = {};
#pragma unroll
        for (int d0 = 0; d0 < 4; ++d0) {
            const bf16x8 k1 = *(const LAS bf16x8*)(kp + d0 * 2048 + ((kr0 + 32 + 4 * d0) & 63) * 16);
            p1 = __builtin_amdgcn_mfma_f32_32x32x16_bf16(k1, qr[d0], p1, 0, 0, 0);
        }
        block<MASK>(p1, carry, k0 + 32 + 16 * hi, tq, hi, A.a10, A.a11);
    }
    {
        f32x16 p0 = {};
#pragma unroll
        for (int d0 = 0; d0 < 4; ++d0) {
            const bf16x8 k0f = *(const LAS bf16x8*)(kp + d0 * 2048 + ((kr0 + 4 * d0) & 63) * 16);
            p0 = __builtin_amdgcn_mfma_f32_32x32x16_bf16(k0f, qr[d0], p0, 0, 0, 0);
        }
        block<MASK>(p0, carry, k0 + 16 * hi, tq, hi, A.a00, A.a01);
    }
}
__device__ __forceinline__ void tile_pv(const LAS unsigned char* Vt, f32x16 (&o)[2], int lane, const AFrag& A) {
    const int hi = lane >> 5, g1 = (lane >> 4) & 1, q4 = (lane & 15) >> 2, pp = lane & 3;
    const LAS unsigned char* vp = Vt + (16 * hi + q4) * 64 + g1 * 32 + pp * 8;
#pragma unroll
    for (int d0 = 0; d0 < 2; ++d0) {
#pragma unroll
        for (int blk = 1; blk >= 0; --blk) {
#pragma unroll
            for (int s = 0; s < 2; ++s) {
                const LAS unsigned char* a = vp + d0 * 4096 + (32 * blk + 8 * s) * 64;
                const v4i16_t lo = __builtin_amdgcn_ds_read_tr16_b64_v4i16((LAS v4i16_t*)a);
                const v4i16_t hh = __builtin_amdgcn_ds_read_tr16_b64_v4i16((LAS v4i16_t*)(a + 256));
                const bf16x8 vf = {lo[0], lo[1], lo[2], lo[3], hh[0], hh[1], hh[2], hh[3]};
                const v4u pa = blk ? (s ? A.a11 : A.a10) : (s ? A.a01 : A.a00);
                o[d0] = __builtin_amdgcn_mfma_f32_32x32x16_bf16(__builtin_bit_cast(bf16x8, pa), vf, o[d0], 0, 0, 0);
            }
        }
    }
}
template <bool MASK>
__device__ __forceinline__ void tile(const LAS unsigned char* Kt, const LAS unsigned char* Vt, const bf16x8 (&qr)[4], f32x16 (&o)[2], float& carry, int k0, int tq, int lane) {
    AFrag A; tile_qk<MASK>(Kt, qr, carry, k0, tq, lane, A); tile_pv(Vt, o, lane, A);
}
__device__ __forceinline__ int crow(int r, int hi) { return (r & 3) + 8 * (r >> 2) + 4 * hi; }

__device__ __forceinline__ void wave_unit_prompt(LAS unsigned char* wl, int b, int h, int jq, const bf16* QB, const bf16* KB, const bf16* VB, bf16* ATT, int lane) {
    const int hi = lane >> 5;
    const size_t rowbase = (size_t)b * SEQ; const int q0 = 32 * jq;
    const int tq = q0 + (lane & 31);
    bf16x8 qr[4];
    { const bf16* qp = QB + (rowbase + tq) * AW + h * HD + hi * 8;
#pragma unroll
      for (int d0 = 0; d0 < 4; ++d0) qr[d0] = *(const bf16x8*)(qp + d0 * 16); }
    f32x16 o[2]; o[0] = f32x16{}; o[1] = f32x16{};
    float carry = 0.f;
    const int prow = lane >> 3, pc = lane & 7;
    const bf16* kg = KB + (rowbase + prow) * AW + h * HD + pc * 8; const bf16* vg = VB + (rowbase + prow) * AW + h * HD + pc * 8;
    LAS unsigned char* kw = wl + pc * 1024; LAS unsigned char* vw = wl + 8192 + (pc >> 2) * 4096 + prow * 64 + (pc & 3) * 16;
    int t = (q0 + 30) >> 6;
    v4u kr[8], vr[8];
#pragma unroll
    for (int it = 0; it < 8; ++it) kr[it] = *(const v4u*)(kg + (size_t)(64 * t + 8 * it) * AW);
    for (;;) {
#pragma unroll
        for (int it = 0; it < 8; ++it) *(LAS v4u*)(kw + ((8 * it + prow + 2 * pc) & 63) * 16) = kr[it];
#pragma unroll
        for (int it = 0; it < 8; ++it) vr[it] = *(const v4u*)(vg + (size_t)(64 * t + 8 * it) * AW);
        LDS_WAIT();
        const int k0 = 64 * t; const bool masked = (k0 + 64 > q0);
        AFrag A;
        if (masked) tile_qk<true>(wl, qr, carry, k0, tq, lane, A); else tile_qk<false>(wl, qr, carry, k0, tq, lane, A);
        const bool done = (t == 0) || (!masked && __all(carry >= 160.0f));
#pragma unroll
        for (int it = 0; it < 8; ++it) *(LAS v4u*)(vw + it * 512) = vr[it];
        if (!done) {
#pragma unroll
            for (int it = 0; it < 8; ++it) kr[it] = *(const v4u*)(kg + (size_t)(64 * (t - 1) + 8 * it) * AW);
        }
        LDS_WAIT();
        tile_pv(wl + 8192, o, lane, A);
        LDS_WAIT();
        if (done) break;
        --t;
    }
    bf16* op = ATT + (rowbase + q0) * AW + h * HD + (lane & 31);
#pragma unroll
    for (int d0 = 0; d0 < 2; ++d0)
#pragma unroll
        for (int r = 0; r < 16; ++r) op[(size_t)crow(r, hi) * AW + d0 * 32] = (bf16)f2bf(o[d0][r]);
}

__device__ __forceinline__ void unit_sample(LAS unsigned char* lds, int b, int h, const bf16* QB, const bf16* KB, const bf16* VB, const float* ck, const float* cv, bf16* ATT) {
    const int tid = threadIdx.x, lane = tid & 63, hi = lane >> 5; const int wid = __builtin_amdgcn_readfirstlane(tid >> 6);
    const size_t rowbase = (size_t)MP + (size_t)b * DEC_SEQ;
    const int tq = PAST + (lane & 15);
    bf16x8 qr[4];
    { const bf16* qp = QB + (rowbase + (lane & 15)) * AW + h * HD + hi * 8;
#pragma unroll
      for (int d0 = 0; d0 < 4; ++d0) qr[d0] = *(const bf16x8*)(qp + d0 * 16); }
    f32x16 o[2]; o[0] = f32x16{}; o[1] = f32x16{};
    float carry = 0.f;
    LAS unsigned char* Kt = lds + wid * 16384; LAS unsigned char* Vt = Kt + 8192;
    const int tlo = 2 * wid, thi = (wid == 7) ? 17 : 2 * wid + 2;
    const int rr = lane >> 4, pc = lane & 15;
    for (int t = thi - 1; t >= tlo; --t) {
        if (t < 16) {
            const float* kb_ = ck + (((size_t)b * PAST + (size_t)t * 64) * NH + h) * HD + pc * 4;
            const float* vb_ = cv + (((size_t)b * PAST + (size_t)t * 64) * NH + h) * HD + pc * 4;
            f32x4 kv[16];
#pragma unroll
            for (int it = 0; it < 16; ++it) kv[it] = *(const f32x4*)(kb_ + (size_t)(4 * it + rr) * NH * HD);
#pragma unroll
            for (int it = 0; it < 16; ++it) {
                const int row = 4 * it + rr;
                v2u kw; kw.x = pk2(kv[it][0], kv[it][1]); kw.y = pk2(kv[it][2], kv[it][3]);
                *(LAS v2u*)(Kt + (pc >> 1) * 1024 + ((row + 2 * (pc >> 1)) & 63) * 16 + (pc & 1) * 8) = kw;
            }
#pragma unroll
            for (int it = 0; it < 16; ++it) kv[it] = *(const f32x4*)(vb_ + (size_t)(4 * it + rr) * NH * HD);
#pragma unroll
            for (int it = 0; it < 16; ++it) {
                const int row = 4 * it + rr;
                v2u vw; vw.x = pk2(kv[it][0], kv[it][1]); vw.y = pk2(kv[it][2], kv[it][3]);
                *(LAS v2u*)(Vt + (pc >> 3) * 4096 + row * 64 + (pc & 7) * 8) = vw;
            }
        } else {
#pragma unroll 4
            for (int it = 0; it < 16; ++it) {
                const int row = 4 * it + rr;
                v2u kw = {0u, 0u}, vw = {0u, 0u};
                if (row < DEC_SEQ) { kw = *(const v2u*)(KB + (rowbase + row) * AW + h * HD + pc * 4); vw = *(const v2u*)(VB + (rowbase + row) * AW + h * HD + pc * 4); }
                *(LAS v2u*)(Kt + (pc >> 1) * 1024 + ((row + 2 * (pc >> 1)) & 63) * 16 + (pc & 1) * 8) = kw;
                *(LAS v2u*)(Vt + (pc >> 3) * 4096 + row * 64 + (pc & 7) * 8) = vw;
            }
        }
        LDS_WAIT();
        if (t < 16) tile<false>(Kt, Vt, qr, o, carry, 64 * t, tq, lane);
        else tile<true>(Kt, Vt, qr, o, carry, 64 * t, tq, lane);
        LDS_WAIT();
    }
    LAS float* Ow = (LAS float*)(lds + wid * 16384);
#pragma unroll
    for (int d0 = 0; d0 < 2; ++d0)
#pragma unroll
        for (int r = 0; r < 8; ++r) Ow[crow(r, hi) * 64 + d0 * 32 + (lane & 31)] = o[d0][r];
    if (lane < 16) Ow[1024 + lane] = carry;
    __syncthreads();
    {
        const int q = tid >> 5, dp = (tid & 31) * 2;
        float a0 = 0.f, a1 = 0.f, sc = 1.f;
#pragma unroll
        for (int w = 7; w >= 0; --w) {
            const LAS float* O = (const LAS float*)(lds + w * 16384);
            a0 += sc * O[q * 64 + dp]; a1 += sc * O[q * 64 + dp + 1];
            sc *= __builtin_amdgcn_exp2f(-O[1024 + q]);
        }
        *(unsigned*)(ATT + (rowbase + q) * AW + h * HD + dp) = pk2(a0, a1);
    }
    __syncthreads();
}
}

template <int W>
__device__ __forceinline__ void pool_chunk(int ch, int c, const float* UB, const float* state_pool, bf16* POOLED, float* out) {
    const int r0 = ch * 16; const bool prompt = r0 < MP;
    const int t0 = prompt ? (r0 & (SEQ - 1)) : 0;
    const int bs = prompt ? 0 : ((r0 - MP) >> 4);
    f32x4 v[16 + W - 1];
#pragma unroll
    for (int k = 0; k < W - 1; ++k) {
        const int back = W - 1 - k;
        f32x4 x = {0.f, 0.f, 0.f, 0.f};
        if (prompt) { if (t0 - back >= 0) x = *(const f32x4*)(UB + (size_t)(r0 - back) * PW + c); }
        else x = *(const f32x4*)(state_pool + ((size_t)bs * PSTATE + (PSTATE - back)) * PW + c);
        v[k] = x;
    }
#pragma unroll
    for (int i = 0; i < 16; ++i) v[W - 1 + i] = *(const f32x4*)(UB + (size_t)(r0 + i) * PW + c);
#pragma unroll
    for (int i = 0; i < 16; ++i) {
        f32x4 s = v[i];
#pragma unroll
        for (int j = 1; j < W; ++j) s += v[i + j];
        const int t = t0 + i;
        const float inv = 1.0f / (float)(prompt ? min(t + 1, W) : W);
        const f32x4 own = v[W - 1 + i];
        const f32x4 pv = s * inv - own;
        v2u o; o.x = pk2(pv[0], pv[1]); o.y = pk2(pv[2], pv[3]);
        *(v2u*)(POOLED + (size_t)(r0 + i) * PW + c) = o;
        if (prompt) { if (t >= SEQ - PSTATE) *(f32x4*)(out + O_PP + ((size_t)(r0 >> 11) * PSTATE + (t - (SEQ - PSTATE))) * PW + c) = own; }
        else { if (i >= 1) *(f32x4*)(out + O_PS + ((size_t)bs * PSTATE + (i - 1)) * PW + c) = own; }
    }
}

__global__ void __launch_bounds__(NWAVES * 64, 2) fwd_mega(Args args) {
    extern __shared__ __attribute__((aligned(16))) unsigned char lds_raw[];
    LAS unsigned char* lds = (LAS unsigned char*)lds_raw;
    volatile LAS unsigned* MISC = (volatile LAS unsigned*)(lds + MISC_OFF);
    const int tid = threadIdx.x, lane = tid & 63; const int wave = __builtin_amdgcn_readfirstlane(tid >> 6);
    const int G = gridDim.x; const int bx = blockIdx.x; const int vcu = (G % 8 == 0) ? (bx % 8) * (G / 8) + bx / 8 : bx;
    unsigned char* ws = args.ws; float* out = args.out;
    gu32* ctl = (gu32*)(ws + WS_CTL);
    const float* x_prompt = args.in[0]; const float* x_sample = args.in[1]; const float* cache_k = args.in[2]; const float* cache_v = args.in[3];
    const float* state_pool = args.in[4]; const float* state_conv = args.in[5]; const float* norm_mix = args.in[6]; const float* w_in = args.in[7];
    const float* w_a = args.in[8]; const float* w_b = args.in[9]; const float* pool_w = args.in[10]; const float* pool_scale = args.in[11];
    const float* w_o = args.in[12]; const float* norm_ffn = args.in[13]; const float* w_up = args.in[14]; const float* conv_w = args.in[15];
    const float* conv_b = args.in[16]; const float* w_down = args.in[17]; const float* norm_final = args.in[18];
    bf16* WIN = (bf16*)(ws + WS_WIN); bf16* WA = (bf16*)(ws + WS_WA); bf16* WPB = (bf16*)(ws + WS_WPB); bf16* WO = (bf16*)(ws + WS_WO);
    bf16* WUP = (bf16*)(ws + WS_WUP); bf16* WDN = (bf16*)(ws + WS_WDN);
    float* RSTD1 = (float*)(ws + WS_RSTD1); float* SSQ = (float*)(ws + WS_SSQ); bf16* HALO = (bf16*)(ws + WS_HALO); bf16* X1B = (bf16*)(ws + WS_X1B);
    bf16* XB = (bf16*)(ws + RA_XB); bf16* POOLED = (bf16*)(ws + RA_XB); bf16* QB = (bf16*)(ws + RA_QB); bf16* ATT = QB;
    bf16* KB = (bf16*)(ws + RA_KB); bf16* VB = (bf16*)(ws + RA_VB); bf16* MERGED = KB; float* UB = (float*)(ws + RA_UB); bf16* SG = (bf16*)(ws + RA_SG);
    bf16* UP = (bf16*)(ws + RA_UP);
    float* X1 = out + O_YP;

    for (int u = tid; u < (LDS_BYTES - LDSCTL_OFF) / 4; u += NWAVES * 64) ((LAS unsigned*)(lds + LDSCTL_OFF))[u] = 0u;
    __syncthreads();
    XcdBarrier bar = xcd_barrier_post((unsigned*)(ctl + CW_BAR), MISC + 8);
    unsigned long long ts_prev = 0ull, ts_acc = 0ull; int ts_k = 0;
#define STAMP() do { if (PROBE_MASK) { if (bx == 0 && tid == 0) { const unsigned long long t_ = __builtin_amdgcn_s_memrealtime(); if ((PROBE_MASK >> ts_k) & 1) ts_acc += t_ - ts_prev; ts_prev = t_; } ++ts_k; } } while (0)
    if (PROBE_MASK && bx == 0 && tid == 0) ts_prev = __builtin_amdgcn_s_memrealtime();
    const int gw = vcu * NWAVES + wave, NGW = G * NWAVES;
    const int gt = vcu * (NWAVES * 64) + tid, NGT = G * NWAVES * 64;

    {
        LAS float* scr = (LAS float*)(lds + wave * 16384);
        constexpr int I_IN = (D_MODEL / 64) * (INW / 32), I_A = (AW / 64) * (D_MODEL / 32), I_O = (D_MODEL / 64) * (D_MODEL / 32), I_UP = (D_MODEL / 64) * (FF2 / 32), I_DN = (DFF / 64) * (D_MODEL / 32);
        constexpr int NITEMS = I_IN + I_A + I_O + I_UP + I_DN;
        for (int it = gw; it < NITEMS; it += NGW) {
            int r = it;
            if (r < I_IN) { p0_transpose_item(w_in, norm_mix, D_MODEL, INW, WIN, scr, r, lane); continue; } r -= I_IN;
            if (r < I_A) { p0_transpose_item(w_a, nullptr, AW, D_MODEL, WA, scr, r, lane); continue; } r -= I_A;
            if (r < I_O) { p0_transpose_item(w_o, nullptr, D_MODEL, D_MODEL, WO, scr, r, lane); continue; } r -= I_O;
            if (r < I_UP) { p0_transpose_item(w_up, norm_ffn, D_MODEL, FF2, WUP, scr, r, lane); continue; } r -= I_UP;
            p0_transpose_item(w_down, nullptr, DFF, D_MODEL, WDN, scr, r, lane);
        }
        for (int task = gw; task < 4 * 32 * 16; task += NGW) {
            const int g = task >> 9, c0 = ((task >> 4) & 31) * 4, n = (task & 15) * 64 + lane;
            const float* pw = pool_w + ((size_t)g * PG + c0) * PG; const float* ps = pool_scale + g * PG; const float* wb = w_b + (size_t)g * PG * D_MODEL + n;
            float s0 = 0.f, s1 = 0.f, s2 = 0.f, s3 = 0.f;
#pragma unroll 16
            for (int d = 0; d < PG; ++d) { const float wv = wb[(size_t)d * D_MODEL] * ps[d];
                s0 = fmaf(pw[d], wv, s0); s1 = fmaf(pw[PG + d], wv, s1); s2 = fmaf(pw[2 * PG + d], wv, s2); s3 = fmaf(pw[3 * PG + d], wv, s3); }
            v2u o; o.x = pk2(s0, s1); o.y = pk2(s2, s3);
            *(v2u*)(WPB + (size_t)n * PW + g * PG + c0) = o;
        }
        for (int m = gw; m < M; m += 2 * NGW) {
            const int m2 = m + NGW; const bool has2 = m2 < M; const int mm2 = has2 ? m2 : m;
            const float* xr = (m < MP) ? x_prompt + (size_t)m * D_MODEL : x_sample + (size_t)(m - MP) * D_MODEL;
            const float* xr2 = (mm2 < MP) ? x_prompt + (size_t)mm2 * D_MODEL : x_sample + (size_t)(mm2 - MP) * D_MODEL;
            const GAS f32x4* xv = (const GAS f32x4*)xr + lane; const GAS f32x4* xv2 = (const GAS f32x4*)xr2 + lane;
            f32x4 v[4], u[4]; float s = 0.f, s2 = 0.f;
#pragma unroll
            for (int j = 0; j < 4; ++j) { v[j] = xv[64 * j]; u[j] = xv2[64 * j]; }
#pragma unroll
            for (int j = 0; j < 4; ++j) { s += (v[j].x * v[j].x + v[j].y * v[j].y) + (v[j].z * v[j].z + v[j].w * v[j].w); s2 += (u[j].x * u[j].x + u[j].y * u[j].y) + (u[j].z * u[j].z + u[j].w * u[j].w); }
#pragma unroll
            for (int o = 1; o < 64; o <<= 1) { s += __shfl_xor(s, o); s2 += __shfl_xor(s2, o); }
            if (lane == 0) { RSTD1[m] = 1.0f / sqrtf(s * (1.0f / D_MODEL) + EPS); if (has2) RSTD1[m2] = 1.0f / sqrtf(s2 * (1.0f / D_MODEL) + EPS); }
            GAS v2u* o8 = (GAS v2u*)(XB + (size_t)m * D_MODEL) + lane;
#pragma unroll
            for (int j = 0; j < 4; ++j) { v2u w; w.x = pk2(v[j].x, v[j].y); w.y = pk2(v[j].z, v[j].w); o8[64 * j] = w; }
            if (has2) { GAS v2u* o82 = (GAS v2u*)(XB + (size_t)m2 * D_MODEL) + lane;
#pragma unroll
                for (int j = 0; j < 4; ++j) { v2u w; w.x = pk2(u[j].x, u[j].y); w.y = pk2(u[j].z, u[j].w); o82[64 * j] = w; } }
        }
    }
    xcd_barrier(bar); STAMP();

    {
        pg8::Gemm g{XB, WIN, M, INW, D_MODEL, D_MODEL}; pg8::StaticOrder S; S.init(M, INW, G, bx);
        pg8::EpiIn E{RSTD1, QB, KB, VB, UB, SG, out};
        pg8::gemm_phase<pg8::EpiIn, pg8::StaticOrder, true>(lds, g, S, E);
    }
    xcd_barrier(bar); STAMP();

    {
        for (int u = gw; u < 64 * BATCH * NH; u += NGW) {
            const int jq = u >> 7, bh = u & 127;
            sb::wave_unit_prompt(lds + wave * 16384, bh >> 3, bh & 7, jq, QB, KB, VB, ATT, lane);
        }
        __syncthreads();
        STAMP();
        for (int u = vcu; u < DEC_BATCH * NH; u += G) sb::unit_sample(lds, u >> 3, u & 7, QB, KB, VB, cache_k, cache_v, ATT);
        STAMP();
        for (int task = gt; task < (M / 16) * (PW / 4); task += NGT) {
            const int ch = task >> 7, c = (task & 127) * 4;
            switch (c >> 7) {
                case 0: pool_chunk<2>(ch, c, UB, state_pool, POOLED, out); break;
                case 1: pool_chunk<4>(ch, c, UB, state_pool, POOLED, out); break;
                case 2: pool_chunk<8>(ch, c, UB, state_pool, POOLED, out); break;
                default: pool_chunk<16>(ch, c, UB, state_pool, POOLED, out); break;
            }
        }
    }
    xcd_barrier(bar); STAMP();

    {
        pg8::Gemm g{ATT, WA, M, D_MODEL, AW, AW}; pg8::StaticOrder S; S.init(M, D_MODEL, G, bx);
        pg8::EpiGate<false> E{MERGED, SG, 0};
        pg8::gemm_phase<pg8::EpiGate<false>, pg8::StaticOrder, true>(lds, g, S, E);
    }
    {
        pg8::Gemm g{POOLED, WPB, M, D_MODEL, PW, PW}; pg8::StaticOrder S; S.init(M, D_MODEL, G, bx);
        pg8::EpiGate<true> E{MERGED, SG, 1024};
        pg8::gemm_phase<pg8::EpiGate<true>, pg8::StaticOrder, true>(lds, g, S, E);
    }
    xcd_barrier(bar); STAMP();

    {
        pg8::Gemm g{MERGED, WO, M, D_MODEL, D_MODEL, D_MODEL}; pg8::StaticOrder S; S.init(M, D_MODEL, G, bx);
        pg8::EpiRes1 E{x_prompt, x_sample, X1, X1B, SSQ};
        pg8::gemm_phase<pg8::EpiRes1, pg8::StaticOrder, true>(lds, g, S, E);
    }
    xcd_barrier(bar); STAMP();

    {
        pg8::Gemm g{X1B, WUP, M, FF2, D_MODEL, D_MODEL}; pg8::StaticOrder S; S.init(M, FF2, G, bx);
        pg8::EpiUp E{SSQ, UP, HALO, out};
        pg8::gemm_phase<pg8::EpiUp, pg8::StaticOrder, true>(lds, g, S, E);
    }
    xcd_barrier(bar); STAMP();

    {
        constexpr int NSEG = M / 32, NCG = DFF / 8;
        for (int task = gt; task < NSEG * NCG; task += NGT) {
            const int seg = task / NCG, c = (task % NCG) * 8; const int r0 = seg * 32;
            const bool prompt = r0 < MP;
            float w0[16], w1[16], w2[16], cb[16], p2[16], p1[16];
#pragma unroll
            for (int hh = 0; hh < 2; ++hh)
#pragma unroll
                for (int e = 0; e < 8; e += 4) {
                    const int cc = c + hh * DFF + e;
                    const f32x4 a = *(const f32x4*)(conv_w + cc), b_ = *(const f32x4*)(conv_w + FF2 + cc), d = *(const f32x4*)(conv_w + 2 * FF2 + cc), bb = *(const f32x4*)(conv_b + cc);
#pragma unroll
                    for (int k = 0; k < 4; ++k) { w0[hh * 8 + e + k] = a[k]; w1[hh * 8 + e + k] = b_[k]; w2[hh * 8 + e + k] = d[k]; cb[hh * 8 + e + k] = bb[k]; }
                }
            if (prompt) {
                if ((r0 & (SEQ - 1)) == 0) {
#pragma unroll
                    for (int k = 0; k < 16; ++k) { p2[k] = 0.f; p1[k] = 0.f; }
                } else {
#pragma unroll
                    for (int hh = 0; hh < 2; ++hh) {
                        const v4u a = *(const v4u*)(HALO + ((size_t)(seg - 1) * 2 + 0) * FF2 + c + hh * DFF), b_ = *(const v4u*)(HALO + ((size_t)(seg - 1) * 2 + 1) * FF2 + c + hh * DFF);
                        p2[hh * 8 + 0] = bflo(a.x); p2[hh * 8 + 1] = bfhi(a.x); p2[hh * 8 + 2] = bflo(a.y); p2[hh * 8 + 3] = bfhi(a.y);
                        p2[hh * 8 + 4] = bflo(a.z); p2[hh * 8 + 5] = bfhi(a.z); p2[hh * 8 + 6] = bflo(a.w); p2[hh * 8 + 7] = bfhi(a.w);
                        p1[hh * 8 + 0] = bflo(b_.x); p1[hh * 8 + 1] = bfhi(b_.x); p1[hh * 8 + 2] = bflo(b_.y); p1[hh * 8 + 3] = bfhi(b_.y);
                        p1[hh * 8 + 4] = bflo(b_.z); p1[hh * 8 + 5] = bfhi(b_.z); p1[hh * 8 + 6] = bflo(b_.w); p1[hh * 8 + 7] = bfhi(b_.w);
                    }
                }
            }
#pragma unroll 2
            for (int i = 0; i < 32; ++i) {
                const int r = r0 + i;
                if (!prompt && (i & 15) == 0) {
                    const float* sc = state_conv + (size_t)((r - MP) >> 4) * 2 * FF2;
#pragma unroll
                    for (int hh = 0; hh < 2; ++hh)
#pragma unroll
                        for (int e = 0; e < 8; e += 4) {
                            const f32x4 a = *(const f32x4*)(sc + c + hh * DFF + e), b_ = *(const f32x4*)(sc + FF2 + c + hh * DFF + e);
#pragma unroll
                            for (int k = 0; k < 4; ++k) { p2[hh * 8 + e + k] = a[k]; p1[hh * 8 + e + k] = b_[k]; }
                        }
                }
                bf16* rowp = UP + (size_t)r * FF2 + c;
                const v4u gv = *(const v4u*)rowp, vv = *(const v4u*)(rowp + DFF);
                float cur[16];
                cur[0] = bflo(gv.x); cur[1] = bfhi(gv.x); cur[2] = bflo(gv.y); cur[3] = bfhi(gv.y); cur[4] = bflo(gv.z); cur[5] = bfhi(gv.z); cur[6] = bflo(gv.w); cur[7] = bfhi(gv.w);
                cur[8] = bflo(vv.x); cur[9] = bfhi(vv.x); cur[10] = bflo(vv.y); cur[11] = bfhi(vv.y); cur[12] = bflo(vv.z); cur[13] = bfhi(vv.z); cur[14] = bflo(vv.w); cur[15] = bfhi(vv.w);
                float act[8];
#pragma unroll
                for (int k = 0; k < 8; ++k) {
                    const float gt_ = cb[k] + w0[k] * p2[k] + w1[k] * p1[k] + w2[k] * cur[k];
                    const float vl = cb[8 + k] + w0[8 + k] * p2[8 + k] + w1[8 + k] * p1[8 + k] + w2[8 + k] * cur[8 + k];
                    const float inner = gt_ * (1.0f + 0.044715f * gt_ * gt_);
                    const float sg = __builtin_amdgcn_rcpf(1.0f + __builtin_amdgcn_exp2f(-2.0f * 0.7978845608028654f * 1.4426950408889634f * inner));
                    act[k] = gt_ * sg * vl;
                }
#pragma unroll
                for (int k = 0; k < 16; ++k) { p2[k] = p1[k]; p1[k] = cur[k]; }
                v4u o; o.x = pk2(act[0], act[1]); o.y = pk2(act[2], act[3]); o.z = pk2(act[4], act[5]); o.w = pk2(act[6], act[7]);
                *(v4u*)rowp = o;
            }
        }
    }
    xcd_barrier(bar); STAMP();

    {
        pg8::Gemm g{UP, WDN, M, D_MODEL, DFF, FF2}; pg8::StaticOrder S; S.init(M, D_MODEL, G, bx);
        pg8::EpiRes2 E{X1};
        pg8::gemm_phase<pg8::EpiRes2, pg8::StaticOrder, true>(lds, g, S, E);
    }
    xcd_barrier(bar); STAMP();

    for (int m = gw; m < M; m += NGW) {
        GAS f32x4* xv = (GAS f32x4*)(X1 + (size_t)m * D_MODEL) + lane;
        f32x4 v[4]; float s = 0.f;
#pragma unroll
        for (int j = 0; j < 4; ++j) { v[j] = xv[64 * j]; s += (v[j].x * v[j].x + v[j].y * v[j].y) + (v[j].z * v[j].z + v[j].w * v[j].w); }
#pragma unroll
        for (int o = 1; o < 64; o <<= 1) s += __shfl_xor(s, o);
        const float rs = 1.0f / sqrtf(s * (1.0f / D_MODEL) + EPS);
#pragma unroll
        for (int j = 0; j < 4; ++j) { const f32x4 gv = *((const f32x4*)norm_final + lane + 64 * j); xv[64 * j] = v[j] * rs * gv; }
    }
    if (PROBE_MASK) { STAMP(); if (bx == 0 && tid == 0) { const unsigned long long t0_ = __builtin_amdgcn_s_memrealtime(); while (__builtin_amdgcn_s_memrealtime() - t0_ < ts_acc * PROBE_MULT) __builtin_amdgcn_s_sleep(8); } }
}

extern "C" void kernel_launch(void* const* d_in, const int* in_sizes, int n_in, void* d_out, int out_size, void* d_ws, size_t ws_size, hipStream_t stream) {
    static int grid = 0;
    if (grid == 0) {
        if (n_in != 19 || (size_t)out_size != O_END || ws_size < WS_END) {
            fprintf(stderr, "kernel_launch: unexpected sizes n_in %d out %d ws %zu (need %zu)\n", n_in, out_size, ws_size, (size_t)WS_END); grid = -1; return; }
        int dev = 0, cus = 0, per_cu = 0;
        if (hipGetDevice(&dev) != hipSuccess || hipDeviceGetAttribute(&cus, hipDeviceAttributeMultiprocessorCount, dev) != hipSuccess) { grid = -1; return; }
        if (hipFuncSetAttribute((const void*)fwd_mega, hipFuncAttributeMaxDynamicSharedMemorySize, LDS_BYTES) != hipSuccess) { fprintf(stderr, "kernel_launch: hipFuncSetAttribute failed\n"); grid = -1; return; }
        if (hipOccupancyMaxActiveBlocksPerMultiprocessor(&per_cu, (const void*)fwd_mega, NWAVES * 64, LDS_BYTES) != hipSuccess || per_cu < 1)
            fprintf(stderr, "kernel_launch: occupancy query reports %d blocks per CU\n", per_cu);
        (void)hipGetLastError();
        grid = cus;
    }
    if (grid < 0) return;
    (void)hipMemsetAsync((char*)d_ws + WS_CTL, 0, CTL_ZERO_BYTES, stream);
    Args a{};
    for (int i = 0; i < 19; ++i) a.in[i] = (const float*)d_in[i];
    a.out = (float*)d_out; a.ws = (unsigned char*)d_ws;
    hipLaunchKernelGGL(fwd_mega, dim3(grid), dim3(NWAVES * 64), LDS_BYTES, stream, a);
}
```

```cpp
#include <hip/hip_runtime.h>
#include <hip/hip_bf16.h>
#include <cstdio>
#include <cstdint>

constexpr int D_MODEL = 1024, BATCH = 16, SEQ = 2048, DEC_BATCH = 32, DEC_SEQ = 16, PAST = 1024;
constexpr int NH = 8, HD = 64, AW = 512, PW = 512, PG = 128, PSTATE = 15, DFF = 2816, FF2 = 5632, INW = 4096;
constexpr int MP = BATCH * SEQ, MS = DEC_BATCH * DEC_SEQ, M = MP + MS;
constexpr float EPS = 1e-6f;
constexpr float C2 = 0.125f * 1.4426950408889634f;

constexpr size_t O_YP = 0;
constexpr size_t O_YS = O_YP + (size_t)MP * D_MODEL;
constexpr size_t O_KP = O_YS + (size_t)MS * D_MODEL;
constexpr size_t O_VP = O_KP + (size_t)MP * AW;
constexpr size_t O_PP = O_VP + (size_t)MP * AW;
constexpr size_t O_CP = O_PP + (size_t)BATCH * PSTATE * PW;
constexpr size_t O_KS = O_CP + (size_t)BATCH * 2 * FF2;
constexpr size_t O_VS = O_KS + (size_t)MS * AW;
constexpr size_t O_PS = O_VS + (size_t)MS * AW;
constexpr size_t O_CS = O_PS + (size_t)DEC_BATCH * PSTATE * PW;
constexpr size_t O_END = O_CS + (size_t)DEC_BATCH * 2 * FF2;

namespace pg8 {
#define PG8_LAS __attribute__((address_space(3)))
typedef unsigned short bf16_t;
typedef short bf16x8 __attribute__((ext_vector_type(8)));
typedef float f32x4 __attribute__((ext_vector_type(4)));
typedef unsigned u32x4 __attribute__((ext_vector_type(4)));
constexpr int BM = 256, BK = 64, HALF = 128, HTB = HALF * BK * 2, STAGE_BYTES = 8 * HTB, NXCD = 8, WGM = 8;

__host__ __device__ __forceinline__ int lds_byte(int r, int c) { const int st = (r >> 4) * 2 + (c >> 5), rr = r & 15, cc = c & 31, ob = rr * 64 + cc * 2; return st * 1024 + (ob ^ (((ob >> 9) & 1) << 5)); }
__host__ __device__ __forceinline__ void stage_rc(int b, int& R, int& C) { const int st = b / 1024, sb = b % 1024, swz = sb ^ (((sb >> 9) & 1) << 5); R = (st >> 1) * 16 + swz / 64; C = (st & 1) * 32 + (swz % 64) / 2; }
__host__ __device__ __forceinline__ int perm32(int rho) { const int n = rho >> 4, i = rho & 15; return 8 * (i >> 2) + 4 * n + (i & 3); }

struct Unit { int pm, pn; };
struct Gemm { const bf16_t* A; const bf16_t* Bt; int M, N, K, lda; };

struct StaticOrder {
    int nM, nN, nwg, G, c;
    __host__ __device__ void init(int M_, int N_, int G_, int c_) { nM = M_ / BM; nN = N_ / BM; nwg = nM * nN; G = G_; c = c_; }
    __host__ __device__ bool next(int i, Unit& u) const {
        const long L = (long)i * G + c; if (L >= nwg) return false;
        int wgid = (int)L; { const int q = nwg / NXCD, r = nwg % NXCD, xcd = wgid % NXCD, off = wgid / NXCD; wgid = (xcd < r ? xcd * (q + 1) : r * (q + 1) + (xcd - r) * q) + off; }
        const int nig = WGM * nN, gid = wgid / nig, fm = gid * WGM, gsz = (nM - fm) < WGM ? (nM - fm) : WGM;
        u.pm = fm + ((wgid % nig) % gsz); u.pn = (wgid % nig) / gsz; return true;
    }
};

__device__ __forceinline__ unsigned cvt_pk_bf16(float lo, float hi) { unsigned r; asm volatile("v_cvt_pk_bf16_f32 %0, %1, %2" : "=v"(r) : "v"(lo), "v"(hi)); return r; }
__device__ __forceinline__ float bf_lo(unsigned u) { return __uint_as_float(u << 16); }
__device__ __forceinline__ float bf_hi(unsigned u) { return __uint_as_float(u & 0xffff0000u); }

template <class Epi, class Sched, bool ALIGN_EPI>
__device__ __forceinline__ void gemm_phase(PG8_LAS unsigned char* lds, const Gemm g, const Sched& S, const Epi& E) {
    int tid = threadIdx.x; asm volatile("" : "+v"(tid));
    const int wid = __builtin_amdgcn_readfirstlane(tid >> 6), lane = tid & 63, wr = wid >> 2, wc = wid & 3, fr = lane & 15, fq = lane >> 4;
    const int K = g.K, nt = K / BK, lda = g.lda;
    unsigned voffA[2], voffB[2];
#pragma unroll
    for (int i = 0; i < 2; ++i) { int R, C; stage_rc(tid * 16 + i * 8192, R, C); const int Rb = Epi::PERM ? ((R & ~31) + perm32(R & 31)) : R;
        voffA[i] = (unsigned)(R * lda + C) * 2u; voffB[i] = (unsigned)(Rb * K + C) * 2u; }
    const size_t kstep = (size_t)(BK * 2);
    const size_t hstepA = (size_t)HALF * lda * 2, hstepB = (size_t)HALF * K * 2;
    const size_t tstepA = 2 * hstepA, tstepB = 2 * hstepB;
    const unsigned ldsw = (unsigned)wid * 1024u;
    const int aoff = lds_byte(wr * 64 + fr, fq * 8), boff = lds_byte(wc * 32 + fr, fq * 8);
#define PG8_SA(b, h) (((b) * 2 + (h)) * HTB)
#define PG8_SB(b, h) ((4 + (b) * 2 + (h)) * HTB)
#define PG8_STAGE(bufoff, gbase, voff) do { _Pragma("unroll") for (int _i = 0; _i < 2; ++_i) \
        __builtin_amdgcn_global_load_lds((const unsigned*)((const char*)(gbase) + (voff)[_i]), (PG8_LAS unsigned*)(lds + (bufoff) + ldsw + _i * 8192), 16, 0, 0); } while (0)
#define PG8_LDA(dst, b, h) do { _Pragma("unroll") for (int m = 0; m < 4; ++m) _Pragma("unroll") for (int k = 0; k < 2; ++k) dst[m][k] = *(const PG8_LAS bf16x8*)(lds + PG8_SA(b, h) + aoff + m * 2048 + k * 1024); } while (0)
#define PG8_LDB(dst, b, h) do { _Pragma("unroll") for (int n = 0; n < 2; ++n) _Pragma("unroll") for (int k = 0; k < 2; ++k) dst[n][k] = *(const PG8_LAS bf16x8*)(lds + PG8_SB(b, h) + boff + n * 2048 + k * 1024); } while (0)
#define PG8_MMA(ai, bj, At, Bt) do { __builtin_amdgcn_s_setprio(1); _Pragma("unroll") for (int m = 0; m < 4; ++m) _Pragma("unroll") for (int n = 0; n < 2; ++n) _Pragma("unroll") for (int k = 0; k < 2; ++k) \
        acc[ai][bj][m][n] = __builtin_amdgcn_mfma_f32_16x16x32_bf16(Bt[n][k], At[m][k], acc[ai][bj][m][n], 0, 0, 0); __builtin_amdgcn_s_setprio(0); } while (0)
#define PG8_WAIT_V(n) asm volatile("s_waitcnt vmcnt(" #n ")" ::: "memory")
#define PG8_WAIT_L(n) asm volatile("s_waitcnt lgkmcnt(" #n ")" ::: "memory")
#define PG8_BAR __builtin_amdgcn_s_barrier()
#define PG8_SCHED __builtin_amdgcn_sched_barrier(0)
    Unit cur, nxt; int ui = 0;
    if (!S.next(0, cur)) return;
    f32x4 acc[2][2][4][2];
#pragma unroll
    for (int a = 0; a < 2; ++a)
#pragma unroll
        for (int b = 0; b < 2; ++b)
#pragma unroll
            for (int m = 0; m < 4; ++m)
#pragma unroll
                for (int n = 0; n < 2; ++n) acc[a][b][m][n] = (f32x4){0.f, 0.f, 0.f, 0.f};
    bf16x8 At[4][2], B0[2][2], B1[2][2];
    const char* cA = (const char*)g.A + (size_t)cur.pm * tstepA; const char* cB = (const char*)g.Bt + (size_t)cur.pn * tstepB;
    PG8_STAGE(PG8_SB(0, 0), cB, voffB); PG8_STAGE(PG8_SB(0, 1), cB + hstepB, voffB); PG8_STAGE(PG8_SA(0, 0), cA, voffA); PG8_STAGE(PG8_SA(0, 1), cA + hstepA, voffA);
    if (wr == 1) PG8_BAR;
    PG8_WAIT_V(2); PG8_BAR;
    PG8_STAGE(PG8_SB(1, 0), cB + kstep, voffB); PG8_STAGE(PG8_SA(1, 0), cA + kstep, voffA); PG8_STAGE(PG8_SB(1, 1), cB + hstepB + kstep, voffB);
    PG8_WAIT_V(6); PG8_BAR;
    for (;;) {
        const bool has_next = S.next(ui + 1, nxt);
        const char* nA = has_next ? (const char*)g.A + (size_t)nxt.pm * tstepA : cA; const char* nB = has_next ? (const char*)g.Bt + (size_t)nxt.pn * tstepB : cB;
        for (int t = 0; t < nt; t += 2) {
            const bool last = (t == nt - 2);
            const char* a1 = cA + (size_t)(t + 1) * kstep;
            const char* a2 = last ? nA : cA + (size_t)(t + 2) * kstep; const char* b2 = last ? nB : cB + (size_t)(t + 2) * kstep;
            const char* a3 = a2 + kstep; const char* b3 = b2 + kstep;
            PG8_LDB(B0, 0, 0); PG8_LDB(B1, 0, 1); PG8_SCHED; PG8_LDA(At, 0, 0); PG8_STAGE(PG8_SA(1, 1), a1 + hstepA, voffA);
            PG8_WAIT_V(8); PG8_WAIT_L(0); PG8_BAR; PG8_MMA(0, 0, At, B0); PG8_MMA(0, 1, At, B1); PG8_BAR; PG8_SCHED;
            PG8_LDA(At, 0, 1); PG8_STAGE(PG8_SB(0, 0), b2, voffB); PG8_STAGE(PG8_SB(0, 1), b2 + hstepB, voffB); PG8_STAGE(PG8_SA(0, 0), a2, voffA);
            PG8_WAIT_V(8); PG8_WAIT_L(0); PG8_BAR; PG8_MMA(1, 0, At, B0); PG8_MMA(1, 1, At, B1); PG8_BAR; PG8_SCHED;
            PG8_LDB(B0, 1, 0); PG8_LDB(B1, 1, 1); PG8_SCHED; PG8_LDA(At, 1, 0); PG8_STAGE(PG8_SA(0, 1), a2 + hstepA, voffA);
            PG8_WAIT_V(8); PG8_WAIT_L(0); PG8_BAR; PG8_MMA(0, 0, At, B0); PG8_MMA(0, 1, At, B1); PG8_BAR; PG8_SCHED;
            PG8_LDA(At, 1, 1); PG8_STAGE(PG8_SB(1, 0), b3, voffB); PG8_STAGE(PG8_SB(1, 1), b3 + hstepB, voffB); PG8_STAGE(PG8_SA(1, 0), a3, voffA);
            PG8_WAIT_V(8); PG8_WAIT_L(0); PG8_BAR; PG8_MMA(1, 0, At, B0); PG8_MMA(1, 1, At, B1); PG8_BAR; PG8_SCHED;
        }
        if constexpr (ALIGN_EPI) { if (wr == 0) PG8_BAR; }
        E(acc, cur, wr, wc, fr, fq);
        if (!has_next) break;
#pragma unroll
        for (int a = 0; a < 2; ++a)
#pragma unroll
            for (int b = 0; b < 2; ++b)
#pragma unroll
                for (int m = 0; m < 4; ++m)
#pragma unroll
                    for (int n = 0; n < 2; ++n) acc[a][b][m][n] = (f32x4){0.f, 0.f, 0.f, 0.f};
        cur = nxt; cA = nA; cB = nB; ++ui;
        if constexpr (ALIGN_EPI) { if (wr == 1) PG8_BAR; }
    }
    PG8_WAIT_V(0);
    if constexpr (!ALIGN_EPI) { if (wr == 0) PG8_BAR; }
    PG8_BAR;
#undef PG8_SA
#undef PG8_SB
#undef PG8_STAGE
#undef PG8_LDA
#undef PG8_LDB
#undef PG8_MMA
#undef PG8_WAIT_V
#undef PG8_WAIT_L
#undef PG8_BAR
#undef PG8_SCHED
}

__device__ __forceinline__ float sigmoid_fast(float x) { return __builtin_amdgcn_rcpf(1.0f + __builtin_amdgcn_exp2f(-1.4426950408889634f * x)); }

struct EpiIn {
    static constexpr bool PERM = true;
    const float* rstd; bf16_t* QB; bf16_t* KB; bf16_t* VB; float* UB; bf16_t* SG; float* out;
    __device__ __forceinline__ void operator()(const f32x4 (&acc)[2][2][4][2], const Unit& u, int wr, int wc, int fr, int fq) const {
        const int pn = u.pn, pm = u.pm;
        bf16_t* db = nullptr; float* df = nullptr; int ldb = 0, ldf = 0, cbase = 0; float mult = 1.f; bool sig = false;
        if (pn < 2) { db = QB; ldb = AW; cbase = 0; mult = C2; }
        else if (pn < 4) { db = KB; ldb = AW; cbase = 512; df = (pm < MP / 256) ? out + O_KP : out + O_KS - (size_t)MP * AW; ldf = AW; }
        else if (pn < 6) { db = VB; ldb = AW; cbase = 1024; df = (pm < MP / 256) ? out + O_VP : out + O_VS - (size_t)MP * AW; ldf = AW; }
        else if (pn < 8) { df = UB; ldf = PW; cbase = 1536; }
        else { db = SG; ldb = 2048; cbase = 2048; sig = true; }
        const int row0 = pm * BM + wr * 64 + fr;
        const int col0 = pn * BM + wc * 32 + 8 * fq - cbase;
#pragma unroll
        for (int ai = 0; ai < 2; ++ai)
#pragma unroll
            for (int m = 0; m < 4; ++m) {
                const int row = row0 + ai * HALF + m * 16;
                const float rs = rstd[row] * mult;
#pragma unroll
                for (int bj = 0; bj < 2; ++bj) {
                    f32x4 v0 = acc[ai][bj][m][0] * rs, v1 = acc[ai][bj][m][1] * rs;
                    const int col = col0 + bj * HALF;
                    if (sig) {
#pragma unroll
                        for (int e = 0; e < 4; ++e) { v0[e] = sigmoid_fast(v0[e]); v1[e] = sigmoid_fast(v1[e]); }
                    }
                    if (db) { u32x4 w; w.x = cvt_pk_bf16(v0[0], v0[1]); w.y = cvt_pk_bf16(v0[2], v0[3]); w.z = cvt_pk_bf16(v1[0], v1[1]); w.w = cvt_pk_bf16(v1[2], v1[3]);
                        *(u32x4*)(db + (size_t)row * ldb + col) = w; }
                    if (df) { float* p = df + (size_t)row * ldf + col; *(f32x4*)p = v0; *(f32x4*)(p + 4) = v1; }
                }
            }
    }
};

template <bool ACCUM> struct EpiGate {
    static constexpr bool PERM = true;
    bf16_t* MG; const bf16_t* SG; int goff;
    __device__ __forceinline__ void operator()(const f32x4 (&acc)[2][2][4][2], const Unit& u, int wr, int wc, int fr, int fq) const {
        const int row0 = u.pm * BM + wr * 64 + fr, col0 = u.pn * BM + wc * 32 + 8 * fq;
#pragma unroll
        for (int ai = 0; ai < 2; ++ai)
#pragma unroll
            for (int m = 0; m < 4; ++m) {
                const int row = row0 + ai * HALF + m * 16;
#pragma unroll
                for (int bj = 0; bj < 2; ++bj) {
                    const int col = col0 + bj * HALF;
                    const u32x4 gv = *(const u32x4*)(SG + (size_t)row * 2048 + goff + col);
                    f32x4 v0 = acc[ai][bj][m][0], v1 = acc[ai][bj][m][1];
                    v0[0] *= bf_lo(gv.x); v0[1] *= bf_hi(gv.x); v0[2] *= bf_lo(gv.y); v0[3] *= bf_hi(gv.y);
                    v1[0] *= bf_lo(gv.z); v1[1] *= bf_hi(gv.z); v1[2] *= bf_lo(gv.w); v1[3] *= bf_hi(gv.w);
                    bf16_t* dp = MG + (size_t)row * D_MODEL + col;
                    if (ACCUM) { const u32x4 ov = *(const u32x4*)dp;
                        v0[0] += bf_lo(ov.x); v0[1] += bf_hi(ov.x); v0[2] += bf_lo(ov.y); v0[3] += bf_hi(ov.y);
                        v1[0] += bf_lo(ov.z); v1[1] += bf_hi(ov.z); v1[2] += bf_lo(ov.w); v1[3] += bf_hi(ov.w); }
                    u32x4 w; w.x = cvt_pk_bf16(v0[0], v0[1]); w.y = cvt_pk_bf16(v0[2], v0[3]); w.z = cvt_pk_bf16(v1[0], v1[1]); w.w = cvt_pk_bf16(v1[2], v1[3]);
                    *(u32x4*)dp = w;
                }
            }
    }
};

struct EpiRes1 {
    static constexpr bool PERM = true;
    const float* xp; const float* xs; float* X1; bf16_t* X1B; float* SSQ;
    __device__ __forceinline__ void operator()(const f32x4 (&acc)[2][2][4][2], const Unit& u, int wr, int wc, int fr, int fq) const {
        const int row0 = u.pm * BM + wr * 64 + fr, col0 = u.pn * BM + wc * 32 + 8 * fq;
        const float* xsrc = (u.pm < MP / 256) ? xp : xs - (size_t)MP * D_MODEL;
#pragma unroll
        for (int ai = 0; ai < 2; ++ai)
#pragma unroll
            for (int m = 0; m < 4; ++m) {
                const int row = row0 + ai * HALF + m * 16; float s = 0.f;
#pragma unroll
                for (int bj = 0; bj < 2; ++bj) {
                    const size_t off = (size_t)row * D_MODEL + col0 + bj * HALF;
                    const f32x4 x0 = *(const f32x4*)(xsrc + off), x1 = *(const f32x4*)(xsrc + off + 4);
                    const f32x4 v0 = acc[ai][bj][m][0] + x0, v1 = acc[ai][bj][m][1] + x1;
                    s += (v0[0] * v0[0] + v0[1] * v0[1]) + (v0[2] * v0[2] + v0[3] * v0[3]) + (v1[0] * v1[0] + v1[1] * v1[1]) + (v1[2] * v1[2] + v1[3] * v1[3]);
                    *(f32x4*)(X1 + off) = v0; *(f32x4*)(X1 + off + 4) = v1;
                    u32x4 w; w.x = cvt_pk_bf16(v0[0], v0[1]); w.y = cvt_pk_bf16(v0[2], v0[3]); w.z = cvt_pk_bf16(v1[0], v1[1]); w.w = cvt_pk_bf16(v1[2], v1[3]);
                    *(u32x4*)(X1B + off) = w;
                }
                s += __shfl_xor(s, 16); s += __shfl_xor(s, 32);
                if (fq == 0) SSQ[(size_t)row * 16 + u.pn * 4 + wc] = s;
            }
    }
};

struct EpiUp {
    static constexpr bool PERM = true;
    const float* SSQ; bf16_t* UP; bf16_t* HALO; float* out;
    __device__ __forceinline__ void operator()(const f32x4 (&acc)[2][2][4][2], const Unit& u, int wr, int wc, int fr, int fq) const {
        const int row0 = u.pm * BM + wr * 64 + fr, col0 = u.pn * BM + wc * 32 + 8 * fq;
        const bool prompt = u.pm < MP / 256;
#pragma unroll
        for (int ai = 0; ai < 2; ++ai)
#pragma unroll
            for (int m = 0; m < 4; ++m) {
                const int row = row0 + ai * HALF + m * 16;
                const f32x4* sp = (const f32x4*)(SSQ + (size_t)row * 16);
                const f32x4 s0 = sp[0], s1 = sp[1], s2 = sp[2], s3 = sp[3];
                const float ss = ((s0[0] + s0[1]) + (s0[2] + s0[3])) + ((s1[0] + s1[1]) + (s1[2] + s1[3])) + ((s2[0] + s2[1]) + (s2[2] + s2[3])) + ((s3[0] + s3[1]) + (s3[2] + s3[3]));
                const float rs = __builtin_amdgcn_rsqf(ss * (1.0f / D_MODEL) + EPS);
                const bool halo = (row & 31) >= 30;
                float* cdst = nullptr;
                if (prompt) { if ((row & (SEQ - 1)) >= SEQ - 2) cdst = out + O_CP + ((size_t)(row >> 11) * 2 + ((row & (SEQ - 1)) - (SEQ - 2))) * FF2; }
                else { if ((row & 15) >= 14) cdst = out + O_CS + ((size_t)((row - MP) >> 4) * 2 + ((row & 15) - 14)) * FF2; }
#pragma unroll
                for (int bj = 0; bj < 2; ++bj) {
                    const int col = col0 + bj * HALF;
                    const f32x4 v0 = acc[ai][bj][m][0] * rs, v1 = acc[ai][bj][m][1] * rs;
                    u32x4 w; w.x = cvt_pk_bf16(v0[0], v0[1]); w.y = cvt_pk_bf16(v0[2], v0[3]); w.z = cvt_pk_bf16(v1[0], v1[1]); w.w = cvt_pk_bf16(v1[2], v1[3]);
                    *(u32x4*)(UP + (size_t)row * FF2 + col) = w;
                    if (halo) *(u32x4*)(HALO + ((size_t)(row >> 5) * 2 + ((row & 31) - 30)) * FF2 + col) = w;
                    if (cdst) { *(f32x4*)(cdst + col) = v0; *(f32x4*)(cdst + col + 4) = v1; }
                }
            }
    }
};

struct EpiRes2 {
    static constexpr bool PERM = true;
    float* X;
    __device__ __forceinline__ void operator()(const f32x4 (&acc)[2][2][4][2], const Unit& u, int wr, int wc, int fr, int fq) const {
        const int row0 = u.pm * BM + wr * 64 + fr, col0 = u.pn * BM + wc * 32 + 8 * fq;
#pragma unroll
        for (int ai = 0; ai < 2; ++ai)
#pragma unroll
            for (int m = 0; m < 4; ++m) {
                const int row = row0 + ai * HALF + m * 16;
#pragma unroll
                for (int bj = 0; bj < 2; ++bj) {
                    float* p = X + (size_t)row * D_MODEL + col0 + bj * HALF;
                    const f32x4 x0 = *(const f32x4*)p, x1 = *(const f32x4*)(p + 4);
                    *(f32x4*)p = acc[ai][bj][m][0] + x0; *(f32x4*)(p + 4) = acc[ai][bj][m][1] + x1;
                }
            }
    }
};
}

#define GAS __attribute__((address_space(1)))
#define LAS __attribute__((address_space(3)))
typedef unsigned short bf16;
typedef unsigned v4u __attribute__((ext_vector_type(4)));
typedef unsigned v2u __attribute__((ext_vector_type(2)));
typedef float f32x4 __attribute__((ext_vector_type(4)));
typedef float f32x16 __attribute__((ext_vector_type(16)));
typedef short bf16x8 __attribute__((ext_vector_type(8)));
typedef short v4i16_t __attribute__((ext_vector_type(4)));
typedef GAS unsigned gu32;
#define RLX_AGENT __ATOMIC_RELAXED, __HIP_MEMORY_SCOPE_AGENT
#define LDS_WAIT() asm volatile("s_waitcnt lgkmcnt(0)" ::: "memory")
#define VM_WAIT() asm volatile("s_waitcnt vmcnt(0)" ::: "memory")
__device__ __forceinline__ unsigned f2bf(float f) { unsigned u = __builtin_bit_cast(unsigned, f); return (u + 0x7fffu + ((u >> 16) & 1u)) >> 16; }
__device__ __forceinline__ unsigned pk2(float lo, float hi) { return f2bf(lo) | (f2bf(hi) << 16); }
__device__ __forceinline__ float bflo(unsigned u) { return __uint_as_float(u << 16); }
__device__ __forceinline__ float bfhi(unsigned u) { return __uint_as_float(u & 0xffff0000u); }

#define XB_TMO      128
#define XB_XCNT(j)  (256  + 64 * (j))
#define XB_XSUB(j)  (1280 + 64 * (j))
#define XB_XGEN(j)  (2304 + 64 * (j))
#define XB_TOP      3328
#define XB_TOPGEN   3392
#define XCD_BAR_WORDS 3456
#define XB_SPIN_CAP (1u << 18)

__device__ __forceinline__ unsigned xb_ld(unsigned* p)              { return __hip_atomic_load(p, __ATOMIC_RELAXED, __HIP_MEMORY_SCOPE_AGENT); }
__device__ __forceinline__ unsigned xb_add(unsigned* p, unsigned v) { return __hip_atomic_fetch_add(p, v, __ATOMIC_RELAXED, __HIP_MEMORY_SCOPE_AGENT); }
__device__ __forceinline__ unsigned xb_xcc_id() { return (unsigned)__builtin_amdgcn_s_getreg((3 << 11) | 20) & 0xFu; }
#define XB_SPIN(cond, bar) do { unsigned _sp = 0; while (cond) { __builtin_amdgcn_s_sleep(1); \
    if ((++_sp & 255u) == 0u) { if (xb_ld(&(bar)[XB_TMO])) break; if (_sp > XB_SPIN_CAP) { atomicAdd(&(bar)[XB_TMO], 1u); break; } } } } while (0)

struct XcdBarrier { unsigned* bar; unsigned x; volatile LAS unsigned* st; };

__device__ __forceinline__ XcdBarrier xcd_barrier_post(unsigned* bar, volatile LAS unsigned* st) {
    XcdBarrier b; b.bar = bar; b.x = xb_xcc_id(); b.st = st;
    if (threadIdx.x == 0) (void)xb_add(&bar[XB_XCNT(b.x)], 1u);
    return b;
}
__device__ __forceinline__ void xcd_barrier_complete(unsigned* bar, unsigned x, unsigned& nloc, unsigned& nx) {
    const unsigned G = gridDim.x * gridDim.y * gridDim.z;
    unsigned sum, cnt, mine, sp = 0u;
    for (;;) {
        sum = 0u; cnt = 0u; mine = 0u;
#pragma unroll
        for (unsigned j = 0; j < 16; ++j) { const unsigned c = xb_ld(&bar[XB_XCNT(j)]); sum += c; cnt += (c > 0u) ? 1u : 0u; mine = (j == x) ? c : mine; }
        if (sum == G) break;
        __builtin_amdgcn_s_sleep(1);
        if ((++sp & 255u) == 0u) { if (xb_ld(&bar[XB_TMO])) break; if (sp > XB_SPIN_CAP) { atomicAdd(&bar[XB_TMO], 1u); break; } }
    }
    nloc = mine > 0u ? mine : 1u; nx = cnt > 0u ? cnt : 1u;
}
__device__ __forceinline__ void xcd_barrier(const XcdBarrier& b) {
    asm volatile("s_waitcnt vmcnt(0)" ::: "memory");
    __syncthreads();
    if (threadIdx.x == 0) {
        unsigned* bar = b.bar;
        __builtin_amdgcn_s_waitcnt(0);
        unsigned nloc = b.st[0], nx = b.st[1];
        if (nloc == 0u) { xcd_barrier_complete(bar, b.x, nloc, nx); b.st[0] = nloc; b.st[1] = nx; }
        const unsigned old = xb_add(&bar[XB_XSUB(b.x)], 1u);
        const unsigned gen = old / nloc;
        if (old + 1u == (gen + 1u) * nloc) {
            __builtin_amdgcn_fence(__ATOMIC_RELEASE, "agent");
            asm volatile("s_waitcnt vmcnt(0)" ::: "memory");
            const unsigned og = xb_add(&bar[XB_TOP], 1u);
            const unsigned tg = og / nx;
            if (og + 1u == (tg + 1u) * nx) xb_add(&bar[XB_TOPGEN], 1u);
            else XB_SPIN(xb_ld(&bar[XB_TOPGEN]) == tg, bar);
            __builtin_amdgcn_fence(__ATOMIC_ACQUIRE, "agent");
            xb_add(&bar[XB_XGEN(b.x)], 1u);
            asm volatile("s_waitcnt vmcnt(0)" ::: "memory");
        } else {
            XB_SPIN(xb_ld(&bar[XB_XGEN(b.x)]) == gen, bar);
            __builtin_amdgcn_fence(__ATOMIC_ACQUIRE, "agent");
            asm volatile("s_waitcnt vmcnt(0)" ::: "memory");
        }
    }
    __syncthreads();
}

constexpr size_t MiB = 1u << 20;
constexpr size_t WS_CTL = 0, CTL_ZERO_BYTES = 1 * MiB;
constexpr size_t WS_WIN = 2 * MiB;
constexpr size_t WS_WA = 10 * MiB;
constexpr size_t WS_WPB = 11 * MiB;
constexpr size_t WS_WO = 12 * MiB;
constexpr size_t WS_WUP = 14 * MiB;
constexpr size_t WS_WDN = 25 * MiB;
constexpr size_t WS_RSTD1 = 31 * MiB;
constexpr size_t WS_SSQ = 32 * MiB;
constexpr size_t WS_SSQS = 34 * MiB + 512 * 1024;
constexpr size_t WS_HALO = 35 * MiB;
constexpr size_t WS_X1B = 58 * MiB;
constexpr size_t WS_RA = 123 * MiB;
constexpr size_t RA_XB = WS_RA;
constexpr size_t RA_QB = WS_RA + (size_t)M * 1024 * 2;
constexpr size_t RA_KB = RA_QB + (size_t)M * 512 * 2;
constexpr size_t RA_VB = RA_KB + (size_t)M * 512 * 2;
constexpr size_t RA_UB = RA_VB + (size_t)M * 512 * 2;
constexpr size_t RA_SG = RA_UB + (size_t)M * 512 * 4;
constexpr size_t RA_END = RA_SG + (size_t)M * 2048 * 2;
constexpr size_t RA_UP = WS_RA;
static_assert(RA_UP + (size_t)M * FF2 * 2 <= RA_END, "UP fits region A");
constexpr size_t WS_END = RA_END;
static_assert(WS_HALO + (size_t)(M / 32) * 2 * FF2 * 2 <= WS_X1B && WS_X1B + (size_t)M * 1024 * 2 <= WS_RA && WS_SSQ + (size_t)M * 64 <= WS_HALO, "ws map");
constexpr int CW_BAR = 4096;

constexpr int RING_BYTES = 131072;
constexpr int LDSCTL_OFF = RING_BYTES, MISC_OFF = LDSCTL_OFF + 320;
constexpr int LDS_BYTES = 147456;
constexpr int NWAVES = 8;

struct Args {
    const float* in[19]; float* out; unsigned char* ws;
};
#ifndef PROBE_MASK
#define PROBE_MASK 0
#endif
#ifndef PROBE_MULT
#define PROBE_MULT 4
#endif

__device__ __forceinline__ void p0_transpose_item(const float* W, const float* gk, int K, int N, bf16* WT, LAS float* scr, int item, int lane) {
    const int nblk = N / 32, kb = item / nblk, nb = item % nblk, k0 = 64 * kb, n0 = 32 * nb;
#pragma unroll 8
    for (int i = 0; i < 32; ++i) { const int kk = 2 * i + (lane >> 5); float v = W[(size_t)(k0 + kk) * N + n0 + (lane & 31)]; if (gk) v *= gk[k0 + kk]; scr[kk * 33 + (lane & 31)] = v; }
    LDS_WAIT(); asm volatile("" ::: "memory");
    const int c = lane & 7;
#pragma unroll
    for (int j = 0; j < 4; ++j) { const int n = (lane >> 3) + 8 * j; const LAS float* s = scr + (8 * c) * 33 + n;
        v4u o; o.x = pk2(s[0 * 33], s[1 * 33]); o.y = pk2(s[2 * 33], s[3 * 33]); o.z = pk2(s[4 * 33], s[5 * 33]); o.w = pk2(s[6 * 33], s[7 * 33]);
        *(GAS v4u*)(WT + (size_t)(n0 + n) * K + k0 + 8 * c) = o; }
    LDS_WAIT(); asm volatile("" ::: "memory");
}

namespace sb {
__device__ __forceinline__ int pi32(int i) { return 16 * ((i >> 2) & 1) + (i & 3) + 4 * (i >> 3); }
__device__ __forceinline__ unsigned cvtpk(float lo, float hi) { typedef float f2 __attribute__((ext_vector_type(2))); typedef __bf16 b2 __attribute__((ext_vector_type(2))); f2 v = {lo, hi}; b2 b = __builtin_convertvector(v, b2); return __builtin_bit_cast(unsigned, b); }

template <bool MASK>
__device__ __forceinline__ void block(f32x16& p, float& carry, int keybase, int tq, int hi, v4u& pa0, v4u& pa1) {
    float sp[16];
#pragma unroll
    for (int r = 0; r < 16; ++r) {
        float e = __builtin_amdgcn_exp2f(__builtin_amdgcn_fmed3f(p[r], -3.0e38f, 126.0f));
        if (MASK) e = (keybase + r >= tq) ? 0.f : e;
        const float f = __builtin_amdgcn_rcpf(1.0f + e);
        sp[r] = f; p[r] = e * f;
    }
    float run = 1.0f;
#pragma unroll
    for (int r = 15; r >= 0; --r) { const float f = sp[r]; sp[r] = run; run *= f; }
    const float T = -__builtin_amdgcn_logf(run);
    const auto rr = __builtin_amdgcn_permlane32_swap(__float_as_uint(T), __float_as_uint(T), false, false);
    const float other = hi ? __uint_as_float(rr[0]) : __uint_as_float(rr[1]);
    const float F = __builtin_amdgcn_exp2f(-(carry + (hi ? 0.f : other)));
#pragma unroll
    for (int r = 0; r < 16; ++r) p[r] = p[r] * (sp[r] * F);
    carry += T + other;
    pa0 = (v4u){cvtpk(p[0], p[1]), cvtpk(p[2], p[3]), cvtpk(p[4], p[5]), cvtpk(p[6], p[7])};
    pa1 = (v4u){cvtpk(p[8], p[9]), cvtpk(p[10], p[11]), cvtpk(p[12], p[13]), cvtpk(p[14], p[15])};
}

struct AFrag { v4u a10, a11, a00, a01; };
template <bool MASK>
__device__ __forceinline__ void tile_qk(const LAS unsigned char* Kt, const bf16x8 (&qr)[4], float& carry, int k0, int tq, int lane, AFrag& A) {
    const int i = lane & 31, hi = lane >> 5;
    const LAS unsigned char* kp = Kt + hi * 1024; const int kr0 = pi32(i) + 2 * hi;
    {
        f32x16 p1 = {};
#pragma unroll
        for (int d0 = 0; d0 < 4; ++d0) {
            const bf16x8 k1 = *(const LAS bf16x8*)(kp + d0 * 2048 + ((kr0 + 32 + 4 * d0) & 63) * 16);
            p1 = __builtin_amdgcn_mfma_f32_32x32x16_bf16(k1, qr[d0], p1, 0, 0, 0);
        }
        block<MASK>(p1, carry, k0 + 32 + 16 * hi, tq, hi, A.a10, A.a11);
    }
    {
        f32x16 p0 = {};
#pragma unroll
        for (int d0 = 0; d0 < 4; ++d0) {
            const bf16x8 k0f = *(const LAS bf16x8*)(kp + d0 * 2048 + ((kr0 + 4 * d0) & 63) * 16);
            p0 = __builtin_amdgcn_mfma_f32_32x32x16_bf16(k0f, qr[d0], p0, 0, 0, 0);
        }
        block<MASK>(p0, carry, k0 + 16 * hi, tq, hi, A.a00, A.a01);
    }
}
__device__ __forceinline__ void tile_pv(const LAS unsigned char* Vt, f32x16 (&o)[2], int lane, const AFrag& A) {
    const int hi = lane >> 5, g1 = (lane >> 4) & 1, q4 = (lane & 15) >> 2, pp = lane & 3;
    const LAS unsigned char* vp = Vt + (16 * hi + q4) * 64 + g1 * 32 + pp * 8;
#pragma unroll
    for (int d0 = 0; d0 < 2; ++d0) {
#pragma unroll
        for (int blk = 1; blk >= 0; --blk) {
#pragma unroll
            for (int s = 0; s < 2; ++s) {
                const LAS unsigned char* a = vp + d0 * 4096 + (32 * blk + 8 * s) * 64;
                const v4i16_t lo = __builtin_amdgcn_ds_read_tr16_b64_v4i16((LAS v4i16_t*)a);
                const v4i16_t hh = __builtin_amdgcn_ds_read_tr16_b64_v4i16((LAS v4i16_t*)(a + 256));
                const bf16x8 vf = {lo[0], lo[1], lo[2], lo[3], hh[0], hh[1], hh[2], hh[3]};
                const v4u pa = blk ? (s ? A.a11 : A.a10) : (s ? A.a01 : A.a00);
                o[d0] = __builtin_amdgcn_mfma_f32_32x32x16_bf16(__builtin_bit_cast(bf16x8, pa), vf, o[d0], 0, 0, 0);
            }
        }
    }
}
template <bool MASK>
__device__ __forceinline__ void tile(const LAS unsigned char* Kt, const LAS unsigned char* Vt, const bf16x8 (&qr)[4], f32x16 (&o)[2], float& carry, int k0, int tq, int lane) {
    AFrag A; tile_qk<MASK>(Kt, qr, carry, k0, tq, lane, A); tile_pv(Vt, o, lane, A);
}
__device__ __forceinline__ int crow(int r, int hi) { return (r & 3) + 8 * (r >> 2) + 4 * hi; }

__device__ __forceinline__ void wave_unit_prompt(LAS unsigned char* wl, int b, int h, int jq, const bf16* QB, const bf16* KB, const bf16* VB, bf16* ATT, int lane) {
    const int hi = lane >> 5;
    const size_t rowbase = (size_t)b * SEQ; const int q0 = 32 * jq;
    const int tq = q0 + (lane & 31);
    bf16x8 qr[4];
    { const bf16* qp = QB + (rowbase + tq) * AW + h * HD + hi * 8;
#pragma unroll
      for (int d0 = 0; d0 < 4; ++d0) qr[d0] = *(const bf16x8*)(qp + d0 * 16); }
    f32x16 o[2]; o[0] = f32x16{}; o[1] = f32x16{};
    float carry = 0.f;
    const int prow = lane >> 3, pc = lane & 7;
    const bf16* kg = KB + (rowbase + prow) * AW + h * HD + pc * 8; const bf16* vg = VB + (rowbase + prow) * AW + h * HD + pc * 8;
    LAS unsigned char* kw = wl + pc * 1024; LAS unsigned char* vw = wl + 8192 + (pc >> 2) * 4096 + prow * 64 + (pc & 3) * 16;
    int t = (q0 + 30) >> 6;
    v4u kr[8], vr[8];
#pragma unroll
    for (int it = 0; it < 8; ++it) kr[it] = *(const v4u*)(kg + (size_t)(64 * t + 8 * it) * AW);
    for (;;) {
#pragma unroll
        for (int it = 0; it < 8; ++it) *(LAS v4u*)(kw + ((8 * it + prow + 2 * pc) & 63) * 16) = kr[it];
#pragma unroll
        for (int it = 0; it < 8; ++it) vr[it] = *(const v4u*)(vg + (size_t)(64 * t + 8 * it) * AW);
        LDS_WAIT();
        const int k0 = 64 * t; const bool masked = (k0 + 64 > q0);
        AFrag A;
        if (masked) tile_qk<true>(wl, qr, carry, k0, tq, lane, A); else tile_qk<false>(wl, qr, carry, k0, tq, lane, A);
        const bool done = (t == 0) || (!masked && __all(carry >= 160.0f));
#pragma unroll
        for (int it = 0; it < 8; ++it) *(LAS v4u*)(vw + it * 512) = vr[it];
        if (!done) {
#pragma unroll
            for (int it = 0; it < 8; ++it) kr[it] = *(const v4u*)(kg + (size_t)(64 * (t - 1) + 8 * it) * AW);
        }
        LDS_WAIT();
        tile_pv(wl + 8192, o, lane, A);
        LDS_WAIT();
        if (done) break;
        --t;
    }
    bf16* op = ATT + (rowbase + q0) * AW + h * HD + (lane & 31);
#pragma unroll
    for (int d0 = 0; d0 < 2; ++d0)
#pragma unroll
        for (int r = 0; r < 16; ++r) op[(size_t)crow(r, hi) * AW + d0 * 32] = (bf16)f2bf(o[d0][r]);
}

__device__ __forceinline__ void unit_sample(LAS unsigned char* lds, int b, int h, const bf16* QB, const bf16* KB, const bf16* VB, const float* ck, const float* cv, bf16* ATT) {
    const int tid = threadIdx.x, lane = tid & 63, hi = lane >> 5; const int wid = __builtin_amdgcn_readfirstlane(tid >> 6);
    const size_t rowbase = (size_t)MP + (size_t)b * DEC_SEQ;
    const int tq = PAST + (lane & 15);
    bf16x8 qr[4];
    { const bf16* qp = QB + (rowbase + (lane & 15)) * AW + h * HD + hi * 8;
#pragma unroll
      for (int d0 = 0; d0 < 4; ++d0) qr[d0] = *(const bf16x8*)(qp + d0 * 16); }
    f32x16 o[2]; o[0] = f32x16{}; o[1] = f32x16{};
    float carry = 0.f;
    LAS unsigned char* Kt = lds + wid * 16384; LAS unsigned char* Vt = Kt + 8192;
    const int tlo = 2 * wid, thi = (wid == 7) ? 17 : 2 * wid + 2;
    const int rr = lane >> 4, pc = lane & 15;
    for (int t = thi - 1; t >= tlo; --t) {
        if (t < 16) {
            const float* kb_ = ck + (((size_t)b * PAST + (size_t)t * 64) * NH + h) * HD + pc * 4;
            const float* vb_ = cv + (((size_t)b * PAST + (size_t)t * 64) * NH + h) * HD + pc * 4;
            f32x4 kv[16];
#pragma unroll
            for (int it = 0; it < 16; ++it) kv[it] = *(const f32x4*)(kb_ + (size_t)(4 * it + rr) * NH * HD);
#pragma unroll
            for (int it = 0; it < 16; ++it) {
                const int row = 4 * it + rr;
                v2u kw; kw.x = pk2(kv[it][0], kv[it][1]); kw.y = pk2(kv[it][2], kv[it][3]);
                *(LAS v2u*)(Kt + (pc >> 1) * 1024 + ((row + 2 * (pc >> 1)) & 63) * 16 + (pc & 1) * 8) = kw;
            }
#pragma unroll
            for (int it = 0; it < 16; ++it) kv[it] = *(const f32x4*)(vb_ + (size_t)(4 * it + rr) * NH * HD);
#pragma unroll
            for (int it = 0; it < 16; ++it) {
                const int row = 4 * it + rr;
                v2u vw; vw.x = pk2(kv[it][0], kv[it][1]); vw.y = pk2(kv[it][2], kv[it][3]);
                *(LAS v2u*)(Vt + (pc >> 3) * 4096 + row * 64 + (pc & 7) * 8) = vw;
            }
        } else {
#pragma unroll 4
            for (int it = 0; it < 16; ++it) {
                const int row = 4 * it + rr;
                v2u kw = {0u, 0u}, vw = {0u, 0u};
                if (row < DEC_SEQ) { kw = *(const v2u*)(KB + (rowbase + row) * AW + h * HD + pc * 4); vw = *(const v2u*)(VB + (rowbase + row) * AW + h * HD + pc * 4); }
                *(LAS v2u*)(Kt + (pc >> 1) * 1024 + ((row + 2 * (pc >> 1)) & 63) * 16 + (pc & 1) * 8) = kw;
                *(LAS v2u*)(Vt + (pc >> 3) * 4096 + row * 64 + (pc & 7) * 8) = vw;
            }
        }
        LDS_WAIT();
        if (t < 16) tile<false>(Kt, Vt, qr, o, carry, 64 * t, tq, lane);
        else tile<true>(Kt, Vt, qr, o, carry, 64 * t, tq, lane);
        LDS_WAIT();
    }
    LAS float* Ow = (LAS float*)(lds + wid * 16384);
#pragma unroll
    for (int d0 = 0; d0 < 2; ++d0)
#pragma unroll
        for (int r = 0; r < 8; ++r) Ow[crow(r, hi) * 64 + d0 * 32 + (lane & 31)] = o[d0][r];
    if (lane < 16) Ow[1024 + lane] = carry;
    __syncthreads();
    {
        const int q = tid >> 5, dp = (tid & 31) * 2;
        float a0 = 0.f, a1 = 0.f, sc = 1.f;
#pragma unroll
        for (int w = 7; w >= 0; --w) {
            const LAS float* O = (const LAS float*)(lds + w * 16384);
            a0 += sc * O[q * 64 + dp]; a1 += sc * O[q * 64 + dp + 1];
            sc *= __builtin_amdgcn_exp2f(-O[1024 + q]);
        }
        *(unsigned*)(ATT + (rowbase + q) * AW + h * HD + dp) = pk2(a0, a1);
    }
    __syncthreads();
}
}

template <int W>
__device__ __forceinline__ void pool_chunk(int ch, int c, const float* UB, const float* state_pool, bf16* POOLED, float* out) {
    const int r0 = ch * 16; const bool prompt = r0 < MP;
    const int t0 = prompt ? (r0 & (SEQ - 1)) : 0;
    const int bs = prompt ? 0 : ((r0 - MP) >> 4);
    f32x4 v[16 + W - 1];
#pragma unroll
    for (int k = 0; k < W - 1; ++k) {
        const int back = W - 1 - k;
        f32x4 x = {0.f, 0.f, 0.f, 0.f};
        if (prompt) { if (t0 - back >= 0) x = *(const f32x4*)(UB + (size_t)(r0 - back) * PW + c); }
        else x = *(const f32x4*)(state_pool + ((size_t)bs * PSTATE + (PSTATE - back)) * PW + c);
        v[k] = x;
    }
#pragma unroll
    for (int i = 0; i < 16; ++i) v[W - 1 + i] = *(const f32x4*)(UB + (size_t)(r0 + i) * PW + c);
#pragma unroll
    for (int i = 0; i < 16; ++i) {
        f32x4 s = v[i];
#pragma unroll
        for (int j = 1; j < W; ++j) s += v[i + j];
        const int t = t0 + i;
        const float inv = 1.0f / (float)(prompt ? min(t + 1, W) : W);
        const f32x4 own = v[W - 1 + i];
        const f32x4 pv = s * inv - own;
        v2u o; o.x = pk2(pv[0], pv[1]); o.y = pk2(pv[2], pv[3]);
        *(v2u*)(POOLED + (size_t)(r0 + i) * PW + c) = o;
        if (prompt) { if (t >= SEQ - PSTATE) *(f32x4*)(out + O_PP + ((size_t)(r0 >> 11) * PSTATE + (t - (SEQ - PSTATE))) * PW + c) = own; }
        else { if (i >= 1) *(f32x4*)(out + O_PS + ((size_t)bs * PSTATE + (i - 1)) * PW + c) = own; }
    }
}

namespace sg {
typedef float f32x4_ __attribute__((ext_vector_type(4)));
__device__ __forceinline__ void slice_mma(const bf16* A, int lda, const bf16* Bt, int K, int m0, int n0, int wave, int lane, f32x4 (&acc)[4][2]) {
    const int r = lane & 15, kg = lane >> 4, KS = K >> 3, steps = KS >> 5;
    const bf16* ap = A + (size_t)(m0 + r) * lda + wave * KS + kg * 8;
    const bf16* bp = Bt + (size_t)(n0 + r) * K + wave * KS + kg * 8;
    int s = 0;
    for (; s + 1 < steps; s += 2) {
        bf16x8 a[2][4], b[2][2];
#pragma unroll
        for (int h = 0; h < 2; ++h) {
#pragma unroll
            for (int i = 0; i < 4; ++i) a[h][i] = *(const bf16x8*)(ap + (size_t)(16 * i) * lda + (s + h) * 32);
#pragma unroll
            for (int j = 0; j < 2; ++j) b[h][j] = *(const bf16x8*)(bp + (size_t)(16 * j) * K + (s + h) * 32);
        }
#pragma unroll
        for (int h = 0; h < 2; ++h)
#pragma unroll
            for (int i = 0; i < 4; ++i)
#pragma unroll
                for (int j = 0; j < 2; ++j) acc[i][j] = __builtin_amdgcn_mfma_f32_16x16x32_bf16(b[h][j], a[h][i], acc[i][j], 0, 0, 0);
    }
    if (s < steps) {
        bf16x8 a[4], b[2];
#pragma unroll
        for (int i = 0; i < 4; ++i) a[i] = *(const bf16x8*)(ap + (size_t)(16 * i) * lda + s * 32);
#pragma unroll
        for (int j = 0; j < 2; ++j) b[j] = *(const bf16x8*)(bp + (size_t)(16 * j) * K + s * 32);
#pragma unroll
        for (int i = 0; i < 4; ++i)
#pragma unroll
            for (int j = 0; j < 2; ++j) acc[i][j] = __builtin_amdgcn_mfma_f32_16x16x32_bf16(b[j], a[i], acc[i][j], 0, 0, 0);
    }
}
__device__ __forceinline__ f32x4 reduce_tile(LAS unsigned char* lds, const f32x4 (&acc)[4][2], int wave, int lane, int tid) {
    LAS float* P = (LAS float*)lds + wave * 2048;
    const int r = lane & 15, fq = lane >> 4;
#pragma unroll
    for (int i = 0; i < 4; ++i)
#pragma unroll
        for (int j = 0; j < 2; ++j) *(LAS f32x4*)(P + (16 * i + r) * 32 + 16 * j + 4 * fq) = acc[i][j];
    __syncthreads();
    const LAS float* Q = (const LAS float*)lds + (tid >> 3) * 32 + (tid & 7) * 4;
    f32x4 v = *(const LAS f32x4*)Q;
#pragma unroll
    for (int w = 1; w < 8; ++w) v += *(const LAS f32x4*)(Q + w * 2048);
    __syncthreads();
    return v;
}
template <class Epi>
__device__ __forceinline__ void phase(LAS unsigned char* lds, const bf16* A, int lda, const bf16* Bt, int K, int N, int vcu, int G, const Epi& E) {
    const int tid = threadIdx.x, lane = tid & 63; const int wave = __builtin_amdgcn_readfirstlane(tid >> 6);
    const int nunits = 8 * (N / 32);
    for (int u = vcu; u < nunits; u += G) {
        const int mt = u & 7, nt = u >> 3;
        f32x4 acc[4][2];
#pragma unroll
        for (int i = 0; i < 4; ++i)
#pragma unroll
            for (int j = 0; j < 2; ++j) acc[i][j] = (f32x4){0.f, 0.f, 0.f, 0.f};
        slice_mma(A, lda, Bt, K, MP + 64 * mt, 32 * nt, wave, lane, acc);
        const f32x4 v = reduce_tile(lds, acc, wave, lane, tid);
        E(MP + 64 * mt + (tid >> 3), 32 * nt + (tid & 7) * 4, nt, v);
    }
}
__device__ __forceinline__ void phase_merge(LAS unsigned char* lds, const bf16* ATT, const bf16* WA, const bf16* POOLED, const bf16* WPB, const bf16* SG, bf16* MERGED, int vcu, int G) {
    const int tid = threadIdx.x, lane = tid & 63; const int wave = __builtin_amdgcn_readfirstlane(tid >> 6);
    for (int u = vcu; u < 8 * (D_MODEL / 32); u += G) {
        const int mt = u & 7, nt = u >> 3;
        f32x4 acc[4][2];
#pragma unroll
        for (int i = 0; i < 4; ++i)
#pragma unroll
            for (int j = 0; j < 2; ++j) acc[i][j] = (f32x4){0.f, 0.f, 0.f, 0.f};
        slice_mma(ATT, AW, WA, AW, MP + 64 * mt, 32 * nt, wave, lane, acc);
        const f32x4 va = reduce_tile(lds, acc, wave, lane, tid);
#pragma unroll
        for (int i = 0; i < 4; ++i)
#pragma unroll
            for (int j = 0; j < 2; ++j) acc[i][j] = (f32x4){0.f, 0.f, 0.f, 0.f};
        slice_mma(POOLED, PW, WPB, PW, MP + 64 * mt, 32 * nt, wave, lane, acc);
        const f32x4 vb = reduce_tile(lds, acc, wave, lane, tid);
        const int row = MP + 64 * mt + (tid >> 3), col = 32 * nt + (tid & 7) * 4;
        const v2u ga = *(const v2u*)(SG + (size_t)row * 2048 + col), gb = *(const v2u*)(SG + (size_t)row * 2048 + 1024 + col);
        const float m0 = bflo(ga.x) * va[0] + bflo(gb.x) * vb[0], m1 = bfhi(ga.x) * va[1] + bfhi(gb.x) * vb[1];
        const float m2 = bflo(ga.y) * va[2] + bflo(gb.y) * vb[2], m3 = bfhi(ga.y) * va[3] + bfhi(gb.y) * vb[3];
        v2u o; o.x = pk2(m0, m1); o.y = pk2(m2, m3);
        *(v2u*)(MERGED + (size_t)row * D_MODEL + col) = o;
    }
}
struct EpiInS {
    const float* rstd; bf16* QB; bf16* KB; bf16* VB; float* UB; bf16* SGp; float* out;
    __device__ __forceinline__ void operator()(int row, int col, int nt, f32x4 v) const {
        const float rs = rstd[row];
        v = v * rs;
        if (col < 512) { v = v * C2; v2u o; o.x = pk2(v[0], v[1]); o.y = pk2(v[2], v[3]); *(v2u*)(QB + (size_t)row * AW + col) = o; }
        else if (col < 1536) {
            const bool isk = col < 1024; const int c = col - (isk ? 512 : 1024);
            v2u o; o.x = pk2(v[0], v[1]); o.y = pk2(v[2], v[3]);
            *(v2u*)((isk ? KB : VB) + (size_t)row * AW + c) = o;
            *(f32x4*)(out + (isk ? O_KS : O_VS) + (size_t)(row - MP) * AW + c) = v;
        }
        else if (col < 2048) { *(f32x4*)(UB + (size_t)row * PW + (col - 1536)) = v; }
        else { v2u o; o.x = pk2(pg8::sigmoid_fast(v[0]), pg8::sigmoid_fast(v[1])); o.y = pk2(pg8::sigmoid_fast(v[2]), pg8::sigmoid_fast(v[3])); *(v2u*)(SGp + (size_t)row * 2048 + (col - 2048)) = o; }
    }
};
struct EpiRes1S {
    const float* xs; float* X1; bf16* X1B; float* SSQS;
    __device__ __forceinline__ void operator()(int row, int col, int nt, f32x4 v) const {
        const f32x4 x = *(const f32x4*)(xs + (size_t)(row - MP) * D_MODEL + col);
        v += x;
        *(f32x4*)(X1 + (size_t)row * D_MODEL + col) = v;
        v2u o; o.x = pk2(v[0], v[1]); o.y = pk2(v[2], v[3]); *(v2u*)(X1B + (size_t)row * D_MODEL + col) = o;
        float s = (v[0] * v[0] + v[1] * v[1]) + (v[2] * v[2] + v[3] * v[3]);
        s += __shfl_xor(s, 1); s += __shfl_xor(s, 2); s += __shfl_xor(s, 4);
        if ((threadIdx.x & 7) == 0) SSQS[(size_t)(row - MP) * 32 + nt] = s;
    }
};
struct EpiUpS {
    const float* SSQS; bf16* UP; float* out;
    __device__ __forceinline__ void operator()(int row, int col, int nt, f32x4 v) const {
        const f32x4* sp = (const f32x4*)(SSQS + (size_t)(row - MP) * 32);
        f32x4 t = sp[0];
#pragma unroll
        for (int k = 1; k < 8; ++k) t += sp[k];
        const float rs = __builtin_amdgcn_rsqf(((t[0] + t[1]) + (t[2] + t[3])) * (1.0f / D_MODEL) + EPS);
        v = v * rs;
        v2u o; o.x = pk2(v[0], v[1]); o.y = pk2(v[2], v[3]); *(v2u*)(UP + (size_t)row * FF2 + col) = o;
        if ((row & 15) >= 14) *(f32x4*)(out + O_CS + ((size_t)((row - MP) >> 4) * 2 + ((row & 15) - 14)) * FF2 + col) = v;
    }
};
struct EpiRes2S {
    float* X;
    __device__ __forceinline__ void operator()(int row, int col, int nt, f32x4 v) const {
        float* p = X + (size_t)row * D_MODEL + col; const f32x4 x = *(const f32x4*)p; *(f32x4*)p = v + x;
    }
};
}

__global__ void __launch_bounds__(NWAVES * 64, 2) fwd_mega(Args args) {
    extern __shared__ __attribute__((aligned(16))) unsigned char lds_raw[];
    LAS unsigned char* lds = (LAS unsigned char*)lds_raw;
    volatile LAS unsigned* MISC = (volatile LAS unsigned*)(lds + MISC_OFF);
    const int tid = threadIdx.x, lane = tid & 63; const int wave = __builtin_amdgcn_readfirstlane(tid >> 6);
    const int G = gridDim.x; const int bx = blockIdx.x; const int vcu = (G % 8 == 0) ? (bx % 8) * (G / 8) + bx / 8 : bx;
    unsigned char* ws = args.ws; float* out = args.out;
    gu32* ctl = (gu32*)(ws + WS_CTL);
    const float* x_prompt = args.in[0]; const float* x_sample = args.in[1]; const float* cache_k = args.in[2]; const float* cache_v = args.in[3];
    const float* state_pool = args.in[4]; const float* state_conv = args.in[5]; const float* norm_mix = args.in[6]; const float* w_in = args.in[7];
    const float* w_a = args.in[8]; const float* w_b = args.in[9]; const float* pool_w = args.in[10]; const float* pool_scale = args.in[11];
    const float* w_o = args.in[12]; const float* norm_ffn = args.in[13]; const float* w_up = args.in[14]; const float* conv_w = args.in[15];
    const float* conv_b = args.in[16]; const float* w_down = args.in[17]; const float* norm_final = args.in[18];
    bf16* WIN = (bf16*)(ws + WS_WIN); bf16* WA = (bf16*)(ws + WS_WA); bf16* WPB = (bf16*)(ws + WS_WPB); bf16* WO = (bf16*)(ws + WS_WO);
    bf16* WUP = (bf16*)(ws + WS_WUP); bf16* WDN = (bf16*)(ws + WS_WDN);
    float* RSTD1 = (float*)(ws + WS_RSTD1); float* SSQ = (float*)(ws + WS_SSQ); float* SSQS = (float*)(ws + WS_SSQS); bf16* HALO = (bf16*)(ws + WS_HALO); bf16* X1B = (bf16*)(ws + WS_X1B);
    bf16* XB = (bf16*)(ws + RA_XB); bf16* POOLED = (bf16*)(ws + RA_XB); bf16* QB = (bf16*)(ws + RA_QB); bf16* ATT = QB;
    bf16* KB = (bf16*)(ws + RA_KB); bf16* VB = (bf16*)(ws + RA_VB); bf16* MERGED = KB; float* UB = (float*)(ws + RA_UB); bf16* SG = (bf16*)(ws + RA_SG);
    bf16* UP = (bf16*)(ws + RA_UP);
    float* X1 = out + O_YP;

    for (int u = tid; u < (LDS_BYTES - LDSCTL_OFF) / 4; u += NWAVES * 64) ((LAS unsigned*)(lds + LDSCTL_OFF))[u] = 0u;
    __syncthreads();
    XcdBarrier bar = xcd_barrier_post((unsigned*)(ctl + CW_BAR), MISC + 8);
    unsigned long long ts_prev = 0ull, ts_acc = 0ull; int ts_k = 0;
#define STAMP() do { if (PROBE_MASK) { if (bx == 0 && tid == 0) { const unsigned long long t_ = __builtin_amdgcn_s_memrealtime(); if ((PROBE_MASK >> ts_k) & 1) ts_acc += t_ - ts_prev; ts_prev = t_; } ++ts_k; } } while (0)
    if (PROBE_MASK && bx == 0 && tid == 0) ts_prev = __builtin_amdgcn_s_memrealtime();
    const int gw = vcu * NWAVES + wave, NGW = G * NWAVES;
    const int gt = vcu * (NWAVES * 64) + tid, NGT = G * NWAVES * 64;

    {
        LAS float* scr = (LAS float*)(lds + wave * 16384);
        constexpr int I_IN = (D_MODEL / 64) * (INW / 32), I_A = (AW / 64) * (D_MODEL / 32), I_O = (D_MODEL / 64) * (D_MODEL / 32), I_UP = (D_MODEL / 64) * (FF2 / 32), I_DN = (DFF / 64) * (D_MODEL / 32);
        constexpr int NITEMS = I_IN + I_A + I_O + I_UP + I_DN;
        for (int it = gw; it < NITEMS; it += NGW) {
            int r = it;
            if (r < I_IN) { p0_transpose_item(w_in, norm_mix, D_MODEL, INW, WIN, scr, r, lane); continue; } r -= I_IN;
            if (r < I_A) { p0_transpose_item(w_a, nullptr, AW, D_MODEL, WA, scr, r, lane); continue; } r -= I_A;
            if (r < I_O) { p0_transpose_item(w_o, nullptr, D_MODEL, D_MODEL, WO, scr, r, lane); continue; } r -= I_O;
            if (r < I_UP) { p0_transpose_item(w_up, norm_ffn, D_MODEL, FF2, WUP, scr, r, lane); continue; } r -= I_UP;
            p0_transpose_item(w_down, nullptr, DFF, D_MODEL, WDN, scr, r, lane);
        }
        for (int task = gw; task < 4 * 32 * 16; task += NGW) {
            const int g = task >> 9, c0 = ((task >> 4) & 31) * 4, n = (task & 15) * 64 + lane;
            const float* pw = pool_w + ((size_t)g * PG + c0) * PG; const float* ps = pool_scale + g * PG; const float* wb = w_b + (size_t)g * PG * D_MODEL + n;
            float s0 = 0.f, s1 = 0.f, s2 = 0.f, s3 = 0.f;
#pragma unroll 16
            for (int d = 0; d < PG; ++d) { const float wv = wb[(size_t)d * D_MODEL] * ps[d];
                s0 = fmaf(pw[d], wv, s0); s1 = fmaf(pw[PG + d], wv, s1); s2 = fmaf(pw[2 * PG + d], wv, s2); s3 = fmaf(pw[3 * PG + d], wv, s3); }
            v2u o; o.x = pk2(s0, s1); o.y = pk2(s2, s3);
            *(v2u*)(WPB + (size_t)n * PW + g * PG + c0) = o;
        }
        for (int m = gw; m < M; m += 2 * NGW) {
            const int m2 = m + NGW; const bool has2 = m2 < M; const int mm2 = has2 ? m2 : m;
            const float* xr = (m < MP) ? x_prompt + (size_t)m * D_MODEL : x_sample + (size_t)(m - MP) * D_MODEL;
            const float* xr2 = (mm2 < MP) ? x_prompt + (size_t)mm2 * D_MODEL : x_sample + (size_t)(mm2 - MP) * D_MODEL;
            const GAS f32x4* xv = (const GAS f32x4*)xr + lane; const GAS f32x4* xv2 = (const GAS f32x4*)xr2 + lane;
            f32x4 v[4], u[4]; float s = 0.f, s2 = 0.f;
#pragma unroll
            for (int j = 0; j < 4; ++j) { v[j] = xv[64 * j]; u[j] = xv2[64 * j]; }
#pragma unroll
            for (int j = 0; j < 4; ++j) { s += (v[j].x * v[j].x + v[j].y * v[j].y) + (v[j].z * v[j].z + v[j].w * v[j].w); s2 += (u[j].x * u[j].x + u[j].y * u[j].y) + (u[j].z * u[j].z + u[j].w * u[j].w); }
#pragma unroll
            for (int o = 1; o < 64; o <<= 1) { s += __shfl_xor(s, o); s2 += __shfl_xor(s2, o); }
            if (lane == 0) { RSTD1[m] = 1.0f / sqrtf(s * (1.0f / D_MODEL) + EPS); if (has2) RSTD1[m2] = 1.0f / sqrtf(s2 * (1.0f / D_MODEL) + EPS); }
            GAS v2u* o8 = (GAS v2u*)(XB + (size_t)m * D_MODEL) + lane;
#pragma unroll
            for (int j = 0; j < 4; ++j) { v2u w; w.x = pk2(v[j].x, v[j].y); w.y = pk2(v[j].z, v[j].w); o8[64 * j] = w; }
            if (has2) { GAS v2u* o82 = (GAS v2u*)(XB + (size_t)m2 * D_MODEL) + lane;
#pragma unroll
                for (int j = 0; j < 4; ++j) { v2u w; w.x = pk2(u[j].x, u[j].y); w.y = pk2(u[j].z, u[j].w); o82[64 * j] = w; } }
        }
    }
    xcd_barrier(bar); STAMP();

    {
        pg8::Gemm g{XB, WIN, MP, INW, D_MODEL, D_MODEL}; pg8::StaticOrder S; S.init(MP, INW, G, bx);
        pg8::EpiIn E{RSTD1, QB, KB, VB, UB, SG, out};
        pg8::gemm_phase<pg8::EpiIn, pg8::StaticOrder, true>(lds, g, S, E);
        sg::EpiInS ES{RSTD1, QB, KB, VB, UB, SG, out};
        sg::phase(lds, XB, D_MODEL, WIN, D_MODEL, INW, vcu, G, ES);
    }
    xcd_barrier(bar); STAMP();

    {
        for (int u = gw; u < 64 * BATCH * NH; u += NGW) {
            const int jq = u >> 7, bh = u & 127;
            sb::wave_unit_prompt(lds + wave * 16384, bh >> 3, bh & 7, jq, QB, KB, VB, ATT, lane);
        }
        __syncthreads();
        STAMP();
        for (int u = vcu; u < DEC_BATCH * NH; u += G) sb::unit_sample(lds, u >> 3, u & 7, QB, KB, VB, cache_k, cache_v, ATT);
        STAMP();
        for (int task = gt; task < (M / 16) * (PW / 4); task += NGT) {
            const int ch = task >> 7, c = (task & 127) * 4;
            switch (c >> 7) {
                case 0: pool_chunk<2>(ch, c, UB, state_pool, POOLED, out); break;
                case 1: pool_chunk<4>(ch, c, UB, state_pool, POOLED, out); break;
                case 2: pool_chunk<8>(ch, c, UB, state_pool, POOLED, out); break;
                default: pool_chunk<16>(ch, c, UB, state_pool, POOLED, out); break;
            }
        }
    }
    xcd_barrier(bar); STAMP();

    {
        pg8::Gemm g{ATT, WA, MP, D_MODEL, AW, AW}; pg8::StaticOrder S; S.init(MP, D_MODEL, G, bx);
        pg8::EpiGate<false> E{MERGED, SG, 0};
        pg8::gemm_phase<pg8::EpiGate<false>, pg8::StaticOrder, true>(lds, g, S, E);
    }
    {
        pg8::Gemm g{POOLED, WPB, MP, D_MODEL, PW, PW}; pg8::StaticOrder S; S.init(MP, D_MODEL, G, bx);
        pg8::EpiGate<true> E{MERGED, SG, 1024};
        pg8::gemm_phase<pg8::EpiGate<true>, pg8::StaticOrder, true>(lds, g, S, E);
        sg::phase_merge(lds, ATT, WA, POOLED, WPB, SG, MERGED, vcu, G);
    }
    xcd_barrier(bar); STAMP();

    {
        pg8::Gemm g{MERGED, WO, MP, D_MODEL, D_MODEL, D_MODEL}; pg8::StaticOrder S; S.init(MP, D_MODEL, G, bx);
        pg8::EpiRes1 E{x_prompt, x_sample, X1, X1B, SSQ};
        pg8::gemm_phase<pg8::EpiRes1, pg8::StaticOrder, true>(lds, g, S, E);
        sg::EpiRes1S ES{x_sample, X1, X1B, SSQS};
        sg::phase(lds, MERGED, D_MODEL, WO, D_MODEL, D_MODEL, vcu, G, ES);
    }
    xcd_barrier(bar); STAMP();

    {
        pg8::Gemm g{X1B, WUP, MP, FF2, D_MODEL, D_MODEL}; pg8::StaticOrder S; S.init(MP, FF2, G, bx);
        pg8::EpiUp E{SSQ, UP, HALO, out};
        pg8::gemm_phase<pg8::EpiUp, pg8::StaticOrder, true>(lds, g, S, E);
        sg::EpiUpS ES{SSQS, UP, out};
        sg::phase(lds, X1B, D_MODEL, WUP, D_MODEL, FF2, vcu, G, ES);
    }
    xcd_barrier(bar); STAMP();

    {
        constexpr int NSEG = M / 32, NCG = DFF / 8;
        for (int task = gt; task < NSEG * NCG; task += NGT) {
            const int seg = task / NCG, c = (task % NCG) * 8; const int r0 = seg * 32;
            const bool prompt = r0 < MP;
            float w0[16], w1[16], w2[16], cb[16], p2[16], p1[16];
#pragma unroll
            for (int hh = 0; hh < 2; ++hh)
#pragma unroll
                for (int e = 0; e < 8; e += 4) {
                    const int cc = c + hh * DFF + e;
                    const f32x4 a = *(const f32x4*)(conv_w + cc), b_ = *(const f32x4*)(conv_w + FF2 + cc), d = *(const f32x4*)(conv_w + 2 * FF2 + cc), bb = *(const f32x4*)(conv_b + cc);
#pragma unroll
                    for (int k = 0; k < 4; ++k) { w0[hh * 8 + e + k] = a[k]; w1[hh * 8 + e + k] = b_[k]; w2[hh * 8 + e + k] = d[k]; cb[hh * 8 + e + k] = bb[k]; }
                }
            if (prompt) {
                if ((r0 & (SEQ - 1)) == 0) {
#pragma unroll
                    for (int k = 0; k < 16; ++k) { p2[k] = 0.f; p1[k] = 0.f; }
                } else {
#pragma unroll
                    for (int hh = 0; hh < 2; ++hh) {
                        const v4u a = *(const v4u*)(HALO + ((size_t)(seg - 1) * 2 + 0) * FF2 + c + hh * DFF), b_ = *(const v4u*)(HALO + ((size_t)(seg - 1) * 2 + 1) * FF2 + c + hh * DFF);
                        p2[hh * 8 + 0] = bflo(a.x); p2[hh * 8 + 1] = bfhi(a.x); p2[hh * 8 + 2] = bflo(a.y); p2[hh * 8 + 3] = bfhi(a.y);
                        p2[hh * 8 + 4] = bflo(a.z); p2[hh * 8 + 5] = bfhi(a.z); p2[hh * 8 + 6] = bflo(a.w); p2[hh * 8 + 7] = bfhi(a.w);
                        p1[hh * 8 + 0] = bflo(b_.x); p1[hh * 8 + 1] = bfhi(b_.x); p1[hh * 8 + 2] = bflo(b_.y); p1[hh * 8 + 3] = bfhi(b_.y);
                        p1[hh * 8 + 4] = bflo(b_.z); p1[hh * 8 + 5] = bfhi(b_.z); p1[hh * 8 + 6] = bflo(b_.w); p1[hh * 8 + 7] = bfhi(b_.w);
                    }
                }
            }
#pragma unroll 2
            for (int i = 0; i < 32; ++i) {
                const int r = r0 + i;
                if (!prompt && (i & 15) == 0) {
                    const float* sc = state_conv + (size_t)((r - MP) >> 4) * 2 * FF2;
#pragma unroll
                    for (int hh = 0; hh < 2; ++hh)
#pragma unroll
                        for (int e = 0; e < 8; e += 4) {
                            const f32x4 a = *(const f32x4*)(sc + c + hh * DFF + e), b_ = *(const f32x4*)(sc + FF2 + c + hh * DFF + e);
#pragma unroll
                            for (int k = 0; k < 4; ++k) { p2[hh * 8 + e + k] = a[k]; p1[hh * 8 + e + k] = b_[k]; }
                        }
                }
                bf16* rowp = UP + (size_t)r * FF2 + c;
                const v4u gv = *(const v4u*)rowp, vv = *(const v4u*)(rowp + DFF);
                float cur[16];
                cur[0] = bflo(gv.x); cur[1] = bfhi(gv.x); cur[2] = bflo(gv.y); cur[3] = bfhi(gv.y); cur[4] = bflo(gv.z); cur[5] = bfhi(gv.z); cur[6] = bflo(gv.w); cur[7] = bfhi(gv.w);
                cur[8] = bflo(vv.x); cur[9] = bfhi(vv.x); cur[10] = bflo(vv.y); cur[11] = bfhi(vv.y); cur[12] = bflo(vv.z); cur[13] = bfhi(vv.z); cur[14] = bflo(vv.w); cur[15] = bfhi(vv.w);
                float act[8];
#pragma unroll
                for (int k = 0; k < 8; ++k) {
                    const float gt_ = cb[k] + w0[k] * p2[k] + w1[k] * p1[k] + w2[k] * cur[k];
                    const float vl = cb[8 + k] + w0[8 + k] * p2[8 + k] + w1[8 + k] * p1[8 + k] + w2[8 + k] * cur[8 + k];
                    const float inner = gt_ * (1.0f + 0.044715f * gt_ * gt_);
                    const float sg = __builtin_amdgcn_rcpf(1.0f + __builtin_amdgcn_exp2f(-2.0f * 0.7978845608028654f * 1.4426950408889634f * inner));
                    act[k] = gt_ * sg * vl;
                }
#pragma unroll
                for (int k = 0; k < 16; ++k) { p2[k] = p1[k]; p1[k] = cur[k]; }
                v4u o; o.x = pk2(act[0], act[1]); o.y = pk2(act[2], act[3]); o.z = pk2(act[4], act[5]); o.w = pk2(act[6], act[7]);
                *(v4u*)rowp = o;
            }
        }
    }
    xcd_barrier(bar); STAMP();

    {
        pg8::Gemm g{UP, WDN, MP, D_MODEL, DFF, FF2}; pg8::StaticOrder S; S.init(MP, D_MODEL, G, bx);
        pg8::EpiRes2 E{X1};
        pg8::gemm_phase<pg8::EpiRes2, pg8::StaticOrder, true>(lds, g, S, E);
        sg::EpiRes2S ES{X1};
        sg::phase(lds, UP, FF2, WDN, DFF, D_MODEL, vcu, G, ES);
    }
    xcd_barrier(bar); STAMP();

    for (int m = gw; m < M; m += NGW) {
        GAS f32x4* xv = (GAS f32x4*)(X1 + (size_t)m * D_MODEL) + lane;
        f32x4 v[4]; float s = 0.f;
#pragma unroll
        for (int j = 0; j < 4; ++j) { v[j] = xv[64 * j]; s += (v[j].x * v[j].x + v[j].y * v[j].y) + (v[j].z * v[j].z + v[j].w * v[j].w); }
#pragma unroll
        for (int o = 1; o < 64; o <<= 1) s += __shfl_xor(s, o);
        const float rs = 1.0f / sqrtf(s * (1.0f / D_MODEL) + EPS);
#pragma unroll
        for (int j = 0; j < 4; ++j) { const f32x4 gv = *((const f32x4*)norm_final + lane + 64 * j); xv[64 * j] = v[j] * rs * gv; }
    }
    if (PROBE_MASK) { STAMP(); if (bx == 0 && tid == 0) { const unsigned long long t0_ = __builtin_amdgcn_s_memrealtime(); while (__builtin_amdgcn_s_memrealtime() - t0_ < ts_acc * PROBE_MULT) __builtin_amdgcn_s_sleep(8); } }
}

extern "C" void kernel_launch(void* const* d_in, const int* in_sizes, int n_in, void* d_out, int out_size, void* d_ws, size_t ws_size, hipStream_t stream) {
    static int grid = 0;
    if (grid == 0) {
        if (n_in != 19 || (size_t)out_size != O_END || ws_size < WS_END) {
            fprintf(stderr, "kernel_launch: unexpected sizes n_in %d out %d ws %zu (need %zu)\n", n_in, out_size, ws_size, (size_t)WS_END); grid = -1; return; }
        int dev = 0, cus = 0, per_cu = 0;
        if (hipGetDevice(&dev) != hipSuccess || hipDeviceGetAttribute(&cus, hipDeviceAttributeMultiprocessorCount, dev) != hipSuccess) { grid = -1; return; }
        if (hipFuncSetAttribute((const void*)fwd_mega, hipFuncAttributeMaxDynamicSharedMemorySize, LDS_BYTES) != hipSuccess) { fprintf(stderr, "kernel_launch: hipFuncSetAttribute failed\n"); grid = -1; return; }
        if (hipOccupancyMaxActiveBlocksPerMultiprocessor(&per_cu, (const void*)fwd_mega, NWAVES * 64, LDS_BYTES) != hipSuccess || per_cu < 1)
            fprintf(stderr, "kernel_launch: occupancy query reports %d blocks per CU\n", per_cu);
        (void)hipGetLastError();
        grid = cus;
    }
    if (grid < 0) return;
    (void)hipMemsetAsync((char*)d_ws + WS_CTL, 0, CTL_ZERO_BYTES, stream);
    Args a{};
    for (int i = 0; i < 19; ++i) a.in[i] = (const float*)d_in[i];
    a.out = (float*)d_out; a.ws = (unsigned char*)d_ws;
    hipLaunchKernelGGL(fwd_mega, dim3(grid), dim3(NWAVES * 64), LDS_BYTES, stream, a);
}
```

```cpp
#include <hip/hip_runtime.h>
#include <hip/hip_bf16.h>
#include <cstdio>
#include <cstdint>

constexpr int D_MODEL = 1024, BATCH = 16, SEQ = 2048, DEC_BATCH = 32, DEC_SEQ = 16, PAST = 1024;
constexpr int NH = 8, HD = 64, AW = 512, PW = 512, PG = 128, PSTATE = 15, DFF = 2816, FF2 = 5632, INW = 4096;
constexpr int MP = BATCH * SEQ, MS = DEC_BATCH * DEC_SEQ, M = MP + MS;
constexpr float EPS = 1e-6f;
constexpr float C2 = 0.125f * 1.4426950408889634f;

constexpr size_t O_YP = 0;
constexpr size_t O_YS = O_YP + (size_t)MP * D_MODEL;
constexpr size_t O_KP = O_YS + (size_t)MS * D_MODEL;
constexpr size_t O_VP = O_KP + (size_t)MP * AW;
constexpr size_t O_PP = O_VP + (size_t)MP * AW;
constexpr size_t O_CP = O_PP + (size_t)BATCH * PSTATE * PW;
constexpr size_t O_KS = O_CP + (size_t)BATCH * 2 * FF2;
constexpr size_t O_VS = O_KS + (size_t)MS * AW;
constexpr size_t O_PS = O_VS + (size_t)MS * AW;
constexpr size_t O_CS = O_PS + (size_t)DEC_BATCH * PSTATE * PW;
constexpr size_t O_END = O_CS + (size_t)DEC_BATCH * 2 * FF2;

namespace pg8 {
#define PG8_LAS __attribute__((address_space(3)))
typedef unsigned short bf16_t;
typedef short bf16x8 __attribute__((ext_vector_type(8)));
typedef float f32x4 __attribute__((ext_vector_type(4)));
typedef unsigned u32x4 __attribute__((ext_vector_type(4)));
constexpr int BM = 256, BK = 64, HALF = 128, HTB = HALF * BK * 2, STAGE_BYTES = 8 * HTB, NXCD = 8, WGM = 8;

__host__ __device__ __forceinline__ int lds_byte(int r, int c) { const int st = (r >> 4) * 2 + (c >> 5), rr = r & 15, cc = c & 31, ob = rr * 64 + cc * 2; return st * 1024 + (ob ^ (((ob >> 9) & 1) << 5)); }
__host__ __device__ __forceinline__ void stage_rc(int b, int& R, int& C) { const int st = b / 1024, sb = b % 1024, swz = sb ^ (((sb >> 9) & 1) << 5); R = (st >> 1) * 16 + swz / 64; C = (st & 1) * 32 + (swz % 64) / 2; }
__host__ __device__ __forceinline__ int perm32(int rho) { const int n = rho >> 4, i = rho & 15; return 8 * (i >> 2) + 4 * n + (i & 3); }

struct Unit { int pm, pn; };
struct Gemm { const bf16_t* A; const bf16_t* Bt; int M, N, K, lda; };

struct StaticOrder {
    int nM, nN, nwg, G, c;
    __host__ __device__ void init(int M_, int N_, int G_, int c_) { nM = M_ / BM; nN = N_ / BM; nwg = nM * nN; G = G_; c = c_; }
    __host__ __device__ bool next(int i, Unit& u) const {
        const long L = (long)i * G + c; if (L >= nwg) return false;
        int wgid = (int)L; { const int q = nwg / NXCD, r = nwg % NXCD, xcd = wgid % NXCD, off = wgid / NXCD; wgid = (xcd < r ? xcd * (q + 1) : r * (q + 1) + (xcd - r) * q) + off; }
        const int nig = WGM * nN, gid = wgid / nig, fm = gid * WGM, gsz = (nM - fm) < WGM ? (nM - fm) : WGM;
        u.pm = fm + ((wgid % nig) % gsz); u.pn = (wgid % nig) / gsz; return true;
    }
};

__device__ __forceinline__ unsigned cvt_pk_bf16(float lo, float hi) { unsigned r; asm volatile("v_cvt_pk_bf16_f32 %0, %1, %2" : "=v"(r) : "v"(lo), "v"(hi)); return r; }
__device__ __forceinline__ float bf_lo(unsigned u) { return __uint_as_float(u << 16); }
__device__ __forceinline__ float bf_hi(unsigned u) { return __uint_as_float(u & 0xffff0000u); }

template <class Epi, class Sched, bool ALIGN_EPI>
__device__ __forceinline__ void gemm_phase(PG8_LAS unsigned char* lds, const Gemm g, const Sched& S, const Epi& E) {
    int tid = threadIdx.x; asm volatile("" : "+v"(tid));
    const int wid = __builtin_amdgcn_readfirstlane(tid >> 6), lane = tid & 63, wr = wid >> 2, wc = wid & 3, fr = lane & 15, fq = lane >> 4;
    const int K = g.K, nt = K / BK, lda = g.lda;
    unsigned voffA[2], voffB[2];
#pragma unroll
    for (int i = 0; i < 2; ++i) { int R, C; stage_rc(tid * 16 + i * 8192, R, C); const int Rb = Epi::PERM ? ((R & ~31) + perm32(R & 31)) : R;
        voffA[i] = (unsigned)(R * lda + C) * 2u; voffB[i] = (unsigned)(Rb * K + C) * 2u; }
    const size_t kstep = (size_t)(BK * 2);
    const size_t hstepA = (size_t)HALF * lda * 2, hstepB = (size_t)HALF * K * 2;
    const size_t tstepA = 2 * hstepA, tstepB = 2 * hstepB;
    const unsigned ldsw = (unsigned)wid * 1024u;
    const int aoff = lds_byte(wr * 64 + fr, fq * 8), boff = lds_byte(wc * 32 + fr, fq * 8);
#define PG8_SA(b, h) (((b) * 2 + (h)) * HTB)
#define PG8_SB(b, h) ((4 + (b) * 2 + (h)) * HTB)
#define PG8_STAGE(bufoff, gbase, voff) do { _Pragma("unroll") for (int _i = 0; _i < 2; ++_i) \
        __builtin_amdgcn_global_load_lds((const unsigned*)((const char*)(gbase) + (voff)[_i]), (PG8_LAS unsigned*)(lds + (bufoff) + ldsw + _i * 8192), 16, 0, 0); } while (0)
#define PG8_LDA(dst, b, h) do { _Pragma("unroll") for (int m = 0; m < 4; ++m) _Pragma("unroll") for (int k = 0; k < 2; ++k) dst[m][k] = *(const PG8_LAS bf16x8*)(lds + PG8_SA(b, h) + aoff + m * 2048 + k * 1024); } while (0)
#define PG8_LDB(dst, b, h) do { _Pragma("unroll") for (int n = 0; n < 2; ++n) _Pragma("unroll") for (int k = 0; k < 2; ++k) dst[n][k] = *(const PG8_LAS bf16x8*)(lds + PG8_SB(b, h) + boff + n * 2048 + k * 1024); } while (0)
#define PG8_MMA(ai, bj, At, Bt) do { __builtin_amdgcn_s_setprio(1); _Pragma("unroll") for (int m = 0; m < 4; ++m) _Pragma("unroll") for (int n = 0; n < 2; ++n) _Pragma("unroll") for (int k = 0; k < 2; ++k) \
        acc[ai][bj][m][n] = __builtin_amdgcn_mfma_f32_16x16x32_bf16(Bt[n][k], At[m][k], acc[ai][bj][m][n], 0, 0, 0); __builtin_amdgcn_s_setprio(0); } while (0)
#define PG8_WAIT_V(n) asm volatile("s_waitcnt vmcnt(" #n ")" ::: "memory")
#define PG8_WAIT_L(n) asm volatile("s_waitcnt lgkmcnt(" #n ")" ::: "memory")
#define PG8_BAR __builtin_amdgcn_s_barrier()
#define PG8_SCHED __builtin_amdgcn_sched_barrier(0)
    Unit cur, nxt; int ui = 0;
    if (!S.next(0, cur)) return;
    f32x4 acc[2][2][4][2];
#pragma unroll
    for (int a = 0; a < 2; ++a)
#pragma unroll
        for (int b = 0; b < 2; ++b)
#pragma unroll
            for (int m = 0; m < 4; ++m)
#pragma unroll
                for (int n = 0; n < 2; ++n) acc[a][b][m][n] = (f32x4){0.f, 0.f, 0.f, 0.f};
    bf16x8 At[4][2], B0[2][2], B1[2][2];
    const char* cA = (const char*)g.A + (size_t)cur.pm * tstepA; const char* cB = (const char*)g.Bt + (size_t)cur.pn * tstepB;
    PG8_STAGE(PG8_SB(0, 0), cB, voffB); PG8_STAGE(PG8_SB(0, 1), cB + hstepB, voffB); PG8_STAGE(PG8_SA(0, 0), cA, voffA); PG8_STAGE(PG8_SA(0, 1), cA + hstepA, voffA);
    if (wr == 1) PG8_BAR;
    PG8_WAIT_V(2); PG8_BAR;
    PG8_STAGE(PG8_SB(1, 0), cB + kstep, voffB); PG8_STAGE(PG8_SA(1, 0), cA + kstep, voffA); PG8_STAGE(PG8_SB(1, 1), cB + hstepB + kstep, voffB);
    PG8_WAIT_V(6); PG8_BAR;
    for (;;) {
        const bool has_next = S.next(ui + 1, nxt);
        const char* nA = has_next ? (const char*)g.A + (size_t)nxt.pm * tstepA : cA; const char* nB = has_next ? (const char*)g.Bt + (size_t)nxt.pn * tstepB : cB;
        for (int t = 0; t < nt; t += 2) {
            const bool last = (t == nt - 2);
            const char* a1 = cA + (size_t)(t + 1) * kstep;
            const char* a2 = last ? nA : cA + (size_t)(t + 2) * kstep; const char* b2 = last ? nB : cB + (size_t)(t + 2) * kstep;
            const char* a3 = a2 + kstep; const char* b3 = b2 + kstep;
            PG8_LDB(B0, 0, 0); PG8_LDB(B1, 0, 1); PG8_SCHED; PG8_LDA(At, 0, 0); PG8_STAGE(PG8_SA(1, 1), a1 + hstepA, voffA);
            PG8_WAIT_V(8); PG8_WAIT_L(0); PG8_BAR; PG8_MMA(0, 0, At, B0); PG8_MMA(0, 1, At, B1); PG8_BAR; PG8_SCHED;
            PG8_LDA(At, 0, 1); PG8_STAGE(PG8_SB(0, 0), b2, voffB); PG8_STAGE(PG8_SB(0, 1), b2 + hstepB, voffB); PG8_STAGE(PG8_SA(0, 0), a2, voffA);
            PG8_WAIT_V(8); PG8_WAIT_L(0); PG8_BAR; PG8_MMA(1, 0, At, B0); PG8_MMA(1, 1, At, B1); PG8_BAR; PG8_SCHED;
            PG8_LDB(B0, 1, 0); PG8_LDB(B1, 1, 1); PG8_SCHED; PG8_LDA(At, 1, 0); PG8_STAGE(PG8_SA(0, 1), a2 + hstepA, voffA);
            PG8_WAIT_V(8); PG8_WAIT_L(0); PG8_BAR; PG8_MMA(0, 0, At, B0); PG8_MMA(0, 1, At, B1); PG8_BAR; PG8_SCHED;
            PG8_LDA(At, 1, 1); PG8_STAGE(PG8_SB(1, 0), b3, voffB); PG8_STAGE(PG8_SB(1, 1), b3 + hstepB, voffB); PG8_STAGE(PG8_SA(1, 0), a3, voffA);
            PG8_WAIT_V(8); PG8_WAIT_L(0); PG8_BAR; PG8_MMA(1, 0, At, B0); PG8_MMA(1, 1, At, B1); PG8_BAR; PG8_SCHED;
        }
        if constexpr (ALIGN_EPI) { if (wr == 0) PG8_BAR; }
        E(acc, cur, wr, wc, fr, fq);
        if (!has_next) break;
#pragma unroll
        for (int a = 0; a < 2; ++a)
#pragma unroll
            for (int b = 0; b < 2; ++b)
#pragma unroll
                for (int m = 0; m < 4; ++m)
#pragma unroll
                    for (int n = 0; n < 2; ++n) acc[a][b][m][n] = (f32x4){0.f, 0.f, 0.f, 0.f};
        cur = nxt; cA = nA; cB = nB; ++ui;
        if constexpr (ALIGN_EPI) { if (wr == 1) PG8_BAR; }
    }
    PG8_WAIT_V(0);
    if constexpr (!ALIGN_EPI) { if (wr == 0) PG8_BAR; }
    PG8_BAR;
#undef PG8_SA
#undef PG8_SB
#undef PG8_STAGE
#undef PG8_LDA
#undef PG8_LDB
#undef PG8_MMA
#undef PG8_WAIT_V
#undef PG8_WAIT_L
#undef PG8_BAR
#undef PG8_SCHED
}

__device__ __forceinline__ float sigmoid_fast(float x) { return __builtin_amdgcn_rcpf(1.0f + __builtin_amdgcn_exp2f(-1.4426950408889634f * x)); }

struct EpiIn {
    static constexpr bool PERM = true;
    const float* rstd; bf16_t* QB; bf16_t* KB; bf16_t* VB; float* UB; bf16_t* SG; float* out;
    __device__ __forceinline__ void operator()(const f32x4 (&acc)[2][2][4][2], const Unit& u, int wr, int wc, int fr, int fq) const {
        const int pn = u.pn, pm = u.pm;
        bf16_t* db = nullptr; float* df = nullptr; int ldb = 0, ldf = 0, cbase = 0; float mult = 1.f; bool sig = false;
        if (pn < 2) { db = QB; ldb = AW; cbase = 0; mult = C2; }
        else if (pn < 4) { db = KB; ldb = AW; cbase = 512; df = (pm < MP / 256) ? out + O_KP : out + O_KS - (size_t)MP * AW; ldf = AW; }
        else if (pn < 6) { db = VB; ldb = AW; cbase = 1024; df = (pm < MP / 256) ? out + O_VP : out + O_VS - (size_t)MP * AW; ldf = AW; }
        else if (pn < 8) { df = UB; ldf = PW; cbase = 1536; }
        else { db = SG; ldb = 2048; cbase = 2048; sig = true; }
        const int row0 = pm * BM + wr * 64 + fr;
        const int col0 = pn * BM + wc * 32 + 8 * fq - cbase;
#pragma unroll
        for (int ai = 0; ai < 2; ++ai)
#pragma unroll
            for (int m = 0; m < 4; ++m) {
                const int row = row0 + ai * HALF + m * 16;
                const float rs = rstd[row] * mult;
#pragma unroll
                for (int bj = 0; bj < 2; ++bj) {
                    f32x4 v0 = acc[ai][bj][m][0] * rs, v1 = acc[ai][bj][m][1] * rs;
                    const int col = col0 + bj * HALF;
                    if (sig) {
#pragma unroll
                        for (int e = 0; e < 4; ++e) { v0[e] = sigmoid_fast(v0[e]); v1[e] = sigmoid_fast(v1[e]); }
                    }
                    if (db) { u32x4 w; w.x = cvt_pk_bf16(v0[0], v0[1]); w.y = cvt_pk_bf16(v0[2], v0[3]); w.z = cvt_pk_bf16(v1[0], v1[1]); w.w = cvt_pk_bf16(v1[2], v1[3]);
                        *(u32x4*)(db + (size_t)row * ldb + col) = w; }
                    if (df) { float* p = df + (size_t)row * ldf + col; *(f32x4*)p = v0; *(f32x4*)(p + 4) = v1; }
                }
            }
    }
};

template <bool ACCUM> struct EpiGate {
    static constexpr bool PERM = true;
    bf16_t* MG; const bf16_t* SG; int goff;
    __device__ __forceinline__ void operator()(const f32x4 (&acc)[2][2][4][2], const Unit& u, int wr, int wc, int fr, int fq) const {
        const int row0 = u.pm * BM + wr * 64 + fr, col0 = u.pn * BM + wc * 32 + 8 * fq;
#pragma unroll
        for (int ai = 0; ai < 2; ++ai)
#pragma unroll
            for (int m = 0; m < 4; ++m) {
                const int row = row0 + ai * HALF + m * 16;
#pragma unroll
                for (int bj = 0; bj < 2; ++bj) {
                    const int col = col0 + bj * HALF;
                    const u32x4 gv = *(const u32x4*)(SG + (size_t)row * 2048 + goff + col);
                    f32x4 v0 = acc[ai][bj][m][0], v1 = acc[ai][bj][m][1];
                    v0[0] *= bf_lo(gv.x); v0[1] *= bf_hi(gv.x); v0[2] *= bf_lo(gv.y); v0[3] *= bf_hi(gv.y);
                    v1[0] *= bf_lo(gv.z); v1[1] *= bf_hi(gv.z); v1[2] *= bf_lo(gv.w); v1[3] *= bf_hi(gv.w);
                    bf16_t* dp = MG + (size_t)row * D_MODEL + col;
                    if (ACCUM) { const u32x4 ov = *(const u32x4*)dp;
                        v0[0] += bf_lo(ov.x); v0[1] += bf_hi(ov.x); v0[2] += bf_lo(ov.y); v0[3] += bf_hi(ov.y);
                        v1[0] += bf_lo(ov.z); v1[1] += bf_hi(ov.z); v1[2] += bf_lo(ov.w); v1[3] += bf_hi(ov.w); }
                    u32x4 w; w.x = cvt_pk_bf16(v0[0], v0[1]); w.y = cvt_pk_bf16(v0[2], v0[3]); w.z = cvt_pk_bf16(v1[0], v1[1]); w.w = cvt_pk_bf16(v1[2], v1[3]);
                    *(u32x4*)dp = w;
                }
            }
    }
};

struct EpiRes1 {
    static constexpr bool PERM = true;
    const float* xp; const float* xs; float* X1; bf16_t* X1B; float* SSQ;
    __device__ __forceinline__ void operator()(const f32x4 (&acc)[2][2][4][2], const Unit& u, int wr, int wc, int fr, int fq) const {
        const int row0 = u.pm * BM + wr * 64 + fr, col0 = u.pn * BM + wc * 32 + 8 * fq;
        const float* xsrc = (u.pm < MP / 256) ? xp : xs - (size_t)MP * D_MODEL;
#pragma unroll
        for (int ai = 0; ai < 2; ++ai)
#pragma unroll
            for (int m = 0; m < 4; ++m) {
                const int row = row0 + ai * HALF + m * 16; float s = 0.f;
#pragma unroll
                for (int bj = 0; bj < 2; ++bj) {
                    const size_t off = (size_t)row * D_MODEL + col0 + bj * HALF;
                    const f32x4 x0 = *(const f32x4*)(xsrc + off), x1 = *(const f32x4*)(xsrc + off + 4);
                    const f32x4 v0 = acc[ai][bj][m][0] + x0, v1 = acc[ai][bj][m][1] + x1;
                    s += (v0[0] * v0[0] + v0[1] * v0[1]) + (v0[2] * v0[2] + v0[3] * v0[3]) + (v1[0] * v1[0] + v1[1] * v1[1]) + (v1[2] * v1[2] + v1[3] * v1[3]);
                    *(f32x4*)(X1 + off) = v0; *(f32x4*)(X1 + off + 4) = v1;
                    u32x4 w; w.x = cvt_pk_bf16(v0[0], v0[1]); w.y = cvt_pk_bf16(v0[2], v0[3]); w.z = cvt_pk_bf16(v1[0], v1[1]); w.w = cvt_pk_bf16(v1[2], v1[3]);
                    *(u32x4*)(X1B + off) = w;
                }
                s += __shfl_xor(s, 16); s += __shfl_xor(s, 32);
                if (fq == 0) SSQ[(size_t)row * 16 + u.pn * 4 + wc] = s;
            }
    }
};

struct EpiUp {
    static constexpr bool PERM = true;
    const float* SSQ; bf16_t* UP; bf16_t* HALO; float* out;
    __device__ __forceinline__ void operator()(const f32x4 (&acc)[2][2][4][2], const Unit& u, int wr, int wc, int fr, int fq) const {
        const int row0 = u.pm * BM + wr * 64 + fr, col0 = u.pn * BM + wc * 32 + 8 * fq;
        const bool prompt = u.pm < MP / 256;
#pragma unroll
        for (int ai = 0; ai < 2; ++ai)
#pragma unroll
            for (int m = 0; m < 4; ++m) {
                const int row = row0 + ai * HALF + m * 16;
                const f32x4* sp = (const f32x4*)(SSQ + (size_t)row * 16);
                const f32x4 s0 = sp[0], s1 = sp[1], s2 = sp[2], s3 = sp[3];
                const float ss = ((s0[0] + s0[1]) + (s0[2] + s0[3])) + ((s1[0] + s1[1]) + (s1[2] + s1[3])) + ((s2[0] + s2[1]) + (s2[2] + s2[3])) + ((s3[0] + s3[1]) + (s3[2] + s3[3]));
                const float rs = __builtin_amdgcn_rsqf(ss * (1.0f / D_MODEL) + EPS);
                const bool halo = (row & 31) >= 30;
                float* cdst = nullptr;
                if (prompt) { if ((row & (SEQ - 1)) >= SEQ - 2) cdst = out + O_CP + ((size_t)(row >> 11) * 2 + ((row & (SEQ - 1)) - (SEQ - 2))) * FF2; }
                else { if ((row & 15) >= 14) cdst = out + O_CS + ((size_t)((row - MP) >> 4) * 2 + ((row & 15) - 14)) * FF2; }
#pragma unroll
                for (int bj = 0; bj < 2; ++bj) {
                    const int col = col0 + bj * HALF;
                    const f32x4 v0 = acc[ai][bj][m][0] * rs, v1 = acc[ai][bj][m][1] * rs;
                    u32x4 w; w.x = cvt_pk_bf16(v0[0], v0[1]); w.y = cvt_pk_bf16(v0[2], v0[3]); w.z = cvt_pk_bf16(v1[0], v1[1]); w.w = cvt_pk_bf16(v1[2], v1[3]);
                    *(u32x4*)(UP + (size_t)row * FF2 + col) = w;
                    if (halo) *(u32x4*)(HALO + ((size_t)(row >> 5) * 2 + ((row & 31) - 30)) * FF2 + col) = w;
                    if (cdst) { *(f32x4*)(cdst + col) = v0; *(f32x4*)(cdst + col + 4) = v1; }
                }
            }
    }
};

struct EpiRes2 {
    static constexpr bool PERM = true;
    float* X;
    __device__ __forceinline__ void operator()(const f32x4 (&acc)[2][2][4][2], const Unit& u, int wr, int wc, int fr, int fq) const {
        const int row0 = u.pm * BM + wr * 64 + fr, col0 = u.pn * BM + wc * 32 + 8 * fq;
#pragma unroll
        for (int ai = 0; ai < 2; ++ai)
#pragma unroll
            for (int m = 0; m < 4; ++m) {
                const int row = row0 + ai * HALF + m * 16;
#pragma unroll
                for (int bj = 0; bj < 2; ++bj) {
                    float* p = X + (size_t)row * D_MODEL + col0 + bj * HALF;
                    const f32x4 x0 = *(const f32x4*)p, x1 = *(const f32x4*)(p + 4);
                    *(f32x4*)p = acc[ai][bj][m][0] + x0; *(f32x4*)(p + 4) = acc[ai][bj][m][1] + x1;
                }
            }
    }
};
}

#define GAS __attribute__((address_space(1)))
#define LAS __attribute__((address_space(3)))
typedef unsigned short bf16;
typedef unsigned v4u __attribute__((ext_vector_type(4)));
typedef unsigned v2u __attribute__((ext_vector_type(2)));
typedef float f32x4 __attribute__((ext_vector_type(4)));
typedef float f32x16 __attribute__((ext_vector_type(16)));
typedef short bf16x8 __attribute__((ext_vector_type(8)));
typedef short v4i16_t __attribute__((ext_vector_type(4)));
typedef GAS unsigned gu32;
#define RLX_AGENT __ATOMIC_RELAXED, __HIP_MEMORY_SCOPE_AGENT
#define LDS_WAIT() asm volatile("s_waitcnt lgkmcnt(0)" ::: "memory")
#define VM_WAIT() asm volatile("s_waitcnt vmcnt(0)" ::: "memory")
__device__ __forceinline__ unsigned f2bf(float f) { unsigned u = __builtin_bit_cast(unsigned, f); return (u + 0x7fffu + ((u >> 16) & 1u)) >> 16; }
__device__ __forceinline__ unsigned pk2(float lo, float hi) { return f2bf(lo) | (f2bf(hi) << 16); }
__device__ __forceinline__ float bflo(unsigned u) { return __uint_as_float(u << 16); }
__device__ __forceinline__ float bfhi(unsigned u) { return __uint_as_float(u & 0xffff0000u); }

#define XB_TMO      128
#define XB_XCNT(j)  (256  + 64 * (j))
#define XB_XSUB(j)  (1280 + 64 * (j))
#define XB_XGEN(j)  (2304 + 64 * (j))
#define XB_TOP      3328
#define XB_TOPGEN   3392
#define XCD_BAR_WORDS 3456
#define XB_SPIN_CAP (1u << 18)

__device__ __forceinline__ unsigned xb_ld(unsigned* p)              { return __hip_atomic_load(p, __ATOMIC_RELAXED, __HIP_MEMORY_SCOPE_AGENT); }
__device__ __forceinline__ unsigned xb_add(unsigned* p, unsigned v) { return __hip_atomic_fetch_add(p, v, __ATOMIC_RELAXED, __HIP_MEMORY_SCOPE_AGENT); }
__device__ __forceinline__ unsigned xb_xcc_id() { return (unsigned)__builtin_amdgcn_s_getreg((3 << 11) | 20) & 0xFu; }
#define XB_SPIN(cond, bar) do { unsigned _sp = 0; while (cond) { __builtin_amdgcn_s_sleep(1); \
    if ((++_sp & 255u) == 0u) { if (xb_ld(&(bar)[XB_TMO])) break; if (_sp > XB_SPIN_CAP) { atomicAdd(&(bar)[XB_TMO], 1u); break; } } } } while (0)

struct XcdBarrier { unsigned* bar; unsigned x; volatile LAS unsigned* st; };

__device__ __forceinline__ XcdBarrier xcd_barrier_post(unsigned* bar, volatile LAS unsigned* st) {
    XcdBarrier b; b.bar = bar; b.x = xb_xcc_id(); b.st = st;
    if (threadIdx.x == 0) (void)xb_add(&bar[XB_XCNT(b.x)], 1u);
    return b;
}
__device__ __forceinline__ void xcd_barrier_complete(unsigned* bar, unsigned x, unsigned& nloc, unsigned& nx) {
    const unsigned G = gridDim.x * gridDim.y * gridDim.z;
    unsigned sum, cnt, mine, sp = 0u;
    for (;;) {
        sum = 0u; cnt = 0u; mine = 0u;
#pragma unroll
        for (unsigned j = 0; j < 16; ++j) { const unsigned c = xb_ld(&bar[XB_XCNT(j)]); sum += c; cnt += (c > 0u) ? 1u : 0u; mine = (j == x) ? c : mine; }
        if (sum == G) break;
        __builtin_amdgcn_s_sleep(1);
        if ((++sp & 255u) == 0u) { if (xb_ld(&bar[XB_TMO])) break; if (sp > XB_SPIN_CAP) { atomicAdd(&bar[XB_TMO], 1u); break; } }
    }
    nloc = mine > 0u ? mine : 1u; nx = cnt > 0u ? cnt : 1u;
}
__device__ __forceinline__ void xcd_barrier(const XcdBarrier& b) {
    asm volatile("s_waitcnt vmcnt(0)" ::: "memory");
    __syncthreads();
    if (threadIdx.x == 0) {
        unsigned* bar = b.bar;
        __builtin_amdgcn_s_waitcnt(0);
        unsigned nloc = b.st[0], nx = b.st[1];
        if (nloc == 0u) { xcd_barrier_complete(bar, b.x, nloc, nx); b.st[0] = nloc; b.st[1] = nx; }
        const unsigned old = xb_add(&bar[XB_XSUB(b.x)], 1u);
        const unsigned gen = old / nloc;
        if (old + 1u == (gen + 1u) * nloc) {
            __builtin_amdgcn_fence(__ATOMIC_RELEASE, "agent");
            asm volatile("s_waitcnt vmcnt(0)" ::: "memory");
            const unsigned og = xb_add(&bar[XB_TOP], 1u);
            const unsigned tg = og / nx;
            if (og + 1u == (tg + 1u) * nx) xb_add(&bar[XB_TOPGEN], 1u);
            else XB_SPIN(xb_ld(&bar[XB_TOPGEN]) == tg, bar);
            __builtin_amdgcn_fence(__ATOMIC_ACQUIRE, "agent");
            xb_add(&bar[XB_XGEN(b.x)], 1u);
            asm volatile("s_waitcnt vmcnt(0)" ::: "memory");
        } else {
            XB_SPIN(xb_ld(&bar[XB_XGEN(b.x)]) == gen, bar);
            __builtin_amdgcn_fence(__ATOMIC_ACQUIRE, "agent");
            asm volatile("s_waitcnt vmcnt(0)" ::: "memory");
        }
    }
    __syncthreads();
}

constexpr size_t MiB = 1u << 20;
constexpr size_t WS_CTL = 0, CTL_ZERO_BYTES = 1 * MiB;
constexpr size_t WS_WIN = 2 * MiB;
constexpr size_t WS_WA = 10 * MiB;
constexpr size_t WS_WPB = 11 * MiB;
constexpr size_t WS_WO = 12 * MiB;
constexpr size_t WS_WUP = 14 * MiB;
constexpr size_t WS_WDN = 25 * MiB;
constexpr size_t WS_RSTD1 = 31 * MiB;
constexpr size_t WS_SSQ = 32 * MiB;
constexpr size_t WS_SSQS = 34 * MiB + 512 * 1024;
constexpr size_t WS_HALO = 35 * MiB;
constexpr size_t WS_X1B = 58 * MiB;
constexpr size_t WS_RA = 123 * MiB;
constexpr size_t RA_XB = WS_RA;
constexpr size_t RA_QB = WS_RA + (size_t)M * 1024 * 2;
constexpr size_t RA_KB = RA_QB + (size_t)M * 512 * 2;
constexpr size_t RA_VB = RA_KB + (size_t)M * 512 * 2;
constexpr size_t RA_UB = RA_VB + (size_t)M * 512 * 2;
constexpr size_t RA_SG = RA_UB + (size_t)M * 512 * 4;
constexpr size_t RA_END = RA_SG + (size_t)M * 2048 * 2;
constexpr size_t RA_UP = WS_RA;
static_assert(RA_UP + (size_t)M * FF2 * 2 <= RA_END, "UP fits region A");
constexpr size_t WS_END = RA_END;
static_assert(WS_HALO + (size_t)(M / 32) * 2 * FF2 * 2 <= WS_X1B && WS_X1B + (size_t)M * 1024 * 2 <= WS_RA && WS_SSQ + (size_t)M * 64 <= WS_HALO, "ws map");
constexpr int CW_BAR = 4096;

constexpr int RING_BYTES = 131072;
constexpr int LDSCTL_OFF = RING_BYTES, MISC_OFF = LDSCTL_OFF + 320;
constexpr int LDS_BYTES = 147456;
constexpr int NWAVES = 8;

struct Args {
    const float* in[19]; float* out; unsigned char* ws;
};
#ifndef PROBE_MASK
#define PROBE_MASK 0
#endif
#ifndef PROBE_MULT
#define PROBE_MULT 4
#endif

__device__ __forceinline__ void p0_transpose_item(const float* W, const float* gk, int K, int N, bf16* WT, LAS float* scr, int item, int lane) {
    const int nblk = N / 32, kb = item / nblk, nb = item % nblk, k0 = 64 * kb, n0 = 32 * nb;
    float tv[32];
#pragma unroll
    for (int i = 0; i < 32; ++i) tv[i] = W[(size_t)(k0 + 2 * i + (lane >> 5)) * N + n0 + (lane & 31)];
    if (gk) {
#pragma unroll
        for (int i = 0; i < 32; ++i) tv[i] *= gk[k0 + 2 * i + (lane >> 5)];
    }
#pragma unroll
    for (int i = 0; i < 32; ++i) scr[(2 * i + (lane >> 5)) * 33 + (lane & 31)] = tv[i];
    LDS_WAIT(); asm volatile("" ::: "memory");
    const int c = lane & 7;
#pragma unroll
    for (int j = 0; j < 4; ++j) { const int n = (lane >> 3) + 8 * j; const LAS float* s = scr + (8 * c) * 33 + n;
        v4u o; o.x = pk2(s[0 * 33], s[1 * 33]); o.y = pk2(s[2 * 33], s[3 * 33]); o.z = pk2(s[4 * 33], s[5 * 33]); o.w = pk2(s[6 * 33], s[7 * 33]);
        *(GAS v4u*)(WT + (size_t)(n0 + n) * K + k0 + 8 * c) = o; }
    LDS_WAIT(); asm volatile("" ::: "memory");
}

namespace sb {
__device__ __forceinline__ int pi32(int i) { return 16 * ((i >> 2) & 1) + (i & 3) + 4 * (i >> 3); }
__device__ __forceinline__ unsigned cvtpk(float lo, float hi) { typedef float f2 __attribute__((ext_vector_type(2))); typedef __bf16 b2 __attribute__((ext_vector_type(2))); f2 v = {lo, hi}; b2 b = __builtin_convertvector(v, b2); return __builtin_bit_cast(unsigned, b); }

template <bool MASK>
__device__ __forceinline__ void block(f32x16& p, float& carry, int keybase, int tq, int hi, v4u& pa0, v4u& pa1) {
    float sp[16];
#pragma unroll
    for (int r = 0; r < 16; ++r) {
        float e = __builtin_amdgcn_exp2f(__builtin_amdgcn_fmed3f(p[r], -3.0e38f, 126.0f));
        if (MASK) e = (keybase + r >= tq) ? 0.f : e;
        const float f = __builtin_amdgcn_rcpf(1.0f + e);
        sp[r] = f; p[r] = e * f;
    }
    float run = 1.0f;
#pragma unroll
    for (int r = 15; r >= 0; --r) { const float f = sp[r]; sp[r] = run; run *= f; }
    const float T = -__builtin_amdgcn_logf(run);
    const auto rr = __builtin_amdgcn_permlane32_swap(__float_as_uint(T), __float_as_uint(T), false, false);
    const float other = hi ? __uint_as_float(rr[0]) : __uint_as_float(rr[1]);
    const float F = __builtin_amdgcn_exp2f(-(carry + (hi ? 0.f : other)));
#pragma unroll
    for (int r = 0; r < 16; ++r) p[r] = p[r] * (sp[r] * F);
    carry += T + other;
    pa0 = (v4u){cvtpk(p[0], p[1]), cvtpk(p[2], p[3]), cvtpk(p[4], p[5]), cvtpk(p[6], p[7])};
    pa1 = (v4u){cvtpk(p[8], p[9]), cvtpk(p[10], p[11]), cvtpk(p[12], p[13]), cvtpk(p[14], p[15])};
}

struct AFrag { v4u a10, a11, a00, a01; };
template <bool MASK>
__device__ __forceinline__ void tile_qk(const LAS unsigned char* Kt, const bf16x8 (&qr)[4], float& carry, int k0, int tq, int lane, AFrag& A) {
    const int i = lane & 31, hi = lane >> 5;
    const LAS unsigned char* kp = Kt + hi * 1024; const int kr0 = pi32(i) + 2 * hi;
    {
        f32x16 p1 = {};
#pragma unroll
        for (int d0 = 0; d0 < 4; ++d0) {
            const bf16x8 k1 = *(const LAS bf16x8*)(kp + d0 * 2048 + ((kr0 + 32 + 4 * d0) & 63) * 16);
            p1 = __builtin_amdgcn_mfma_f32_32x32x16_bf16(k1, qr[d0], p1, 0, 0, 0);
        }
        block<MASK>(p1, carry, k0 + 32 + 16 * hi, tq, hi, A.a10, A.a11);
    }
    {
        f32x16 p0 = {};
#pragma unroll
        for (int d0 = 0; d0 < 4; ++d0) {
            const bf16x8 k0f = *(const LAS bf16x8*)(kp + d0 * 2048 + ((kr0 + 4 * d0) & 63) * 16);
            p0 = __builtin_amdgcn_mfma_f32_32x32x16_bf16(k0f, qr[d0], p0, 0, 0, 0);
        }
        block<MASK>(p0, carry, k0 + 16 * hi, tq, hi, A.a00, A.a01);
    }
}
__device__ __forceinline__ void tile_pv(const LAS unsigned char* Vt, f32x16 (&o)[2], int lane, const AFrag& A) {
    const int hi = lane >> 5, g1 = (lane >> 4) & 1, q4 = (lane & 15) >> 2, pp = lane & 3;
    const LAS unsigned char* vp = Vt + (16 * hi + q4) * 64 + g1 * 32 + pp * 8;
#pragma unroll
    for (int d0 = 0; d0 < 2; ++d0) {
#pragma unroll
        for (int blk = 1; blk >= 0; --blk) {
#pragma unroll
            for (int s = 0; s < 2; ++s) {
                const LAS unsigned char* a = vp + d0 * 4096 + (32 * blk + 8 * s) * 64;
                const v4i16_t lo = __builtin_amdgcn_ds_read_tr16_b64_v4i16((LAS v4i16_t*)a);
                const v4i16_t hh = __builtin_amdgcn_ds_read_tr16_b64_v4i16((LAS v4i16_t*)(a + 256));
                const bf16x8 vf = {lo[0], lo[1], lo[2], lo[3], hh[0], hh[1], hh[2], hh[3]};
                const v4u pa = blk ? (s ? A.a11 : A.a10) : (s ? A.a01 : A.a00);
                o[d0] = __builtin_amdgcn_mfma_f32_32x32x16_bf16(__builtin_bit_cast(bf16x8, pa), vf, o[d0], 0, 0, 0);
            }
        }
    }
}
template <bool MASK>
__device__ __forceinline__ void tile(const LAS unsigned char* Kt, const LAS unsigned char* Vt, const bf16x8 (&qr)[4], f32x16 (&o)[2], float& carry, int k0, int tq, int lane) {
    AFrag A; tile_qk<MASK>(Kt, qr, carry, k0, tq, lane, A); tile_pv(Vt, o, lane, A);
}
__device__ __forceinline__ int crow(int r, int hi) { return (r & 3) + 8 * (r >> 2) + 4 * hi; }

__device__ __forceinline__ void wave_unit_prompt(LAS unsigned char* wl, int b, int h, int jq, const bf16* QB, const bf16* KB, const bf16* VB, bf16* ATT, int lane) {
    const int hi = lane >> 5;
    const size_t rowbase = (size_t)b * SEQ; const int q0 = 32 * jq;
    const int tq = q0 + (lane & 31);
    bf16x8 qr[4];
    { const bf16* qp = QB + (rowbase + tq) * AW + h * HD + hi * 8;
#pragma unroll
      for (int d0 = 0; d0 < 4; ++d0) qr[d0] = *(const bf16x8*)(qp + d0 * 16); }
    f32x16 o[2]; o[0] = f32x16{}; o[1] = f32x16{};
    float carry = 0.f;
    const int prow = lane >> 3, pc = lane & 7;
    const bf16* kg = KB + (rowbase + prow) * AW + h * HD + pc * 8; const bf16* vg = VB + (rowbase + prow) * AW + h * HD + pc * 8;
    LAS unsigned char* kw = wl + pc * 1024; LAS unsigned char* vw = wl + 8192 + (pc >> 2) * 4096 + prow * 64 + (pc & 3) * 16;
    int t = (q0 + 30) >> 6;
    v4u kr[8], vr[8];
#pragma unroll
    for (int it = 0; it < 8; ++it) kr[it] = *(const v4u*)(kg + (size_t)(64 * t + 8 * it) * AW);
    for (;;) {
#pragma unroll
        for (int it = 0; it < 8; ++it) *(LAS v4u*)(kw + ((8 * it + prow + 2 * pc) & 63) * 16) = kr[it];
#pragma unroll
        for (int it = 0; it < 8; ++it) vr[it] = *(const v4u*)(vg + (size_t)(64 * t + 8 * it) * AW);
        LDS_WAIT();
        const int k0 = 64 * t; const bool masked = (k0 + 64 > q0);
        AFrag A;
        if (masked) tile_qk<true>(wl, qr, carry, k0, tq, lane, A); else tile_qk<false>(wl, qr, carry, k0, tq, lane, A);
        const bool done = (t == 0) || (!masked && __all(carry >= 160.0f));
#pragma unroll
        for (int it = 0; it < 8; ++it) *(LAS v4u*)(vw + it * 512) = vr[it];
        if (!done) {
#pragma unroll
            for (int it = 0; it < 8; ++it) kr[it] = *(const v4u*)(kg + (size_t)(64 * (t - 1) + 8 * it) * AW);
        }
        LDS_WAIT();
        tile_pv(wl + 8192, o, lane, A);
        LDS_WAIT();
        if (done) break;
        --t;
    }
    bf16* op = ATT + (rowbase + q0) * AW + h * HD + (lane & 31);
#pragma unroll
    for (int d0 = 0; d0 < 2; ++d0)
#pragma unroll
        for (int r = 0; r < 16; ++r) op[(size_t)crow(r, hi) * AW + d0 * 32] = (bf16)f2bf(o[d0][r]);
}

__device__ __forceinline__ void unit_sample(LAS unsigned char* lds, int b, int h, const bf16* QB, const bf16* KB, const bf16* VB, const float* ck, const float* cv, bf16* ATT) {
    int tid = threadIdx.x; asm volatile("" : "+v"(tid)); const int lane = tid & 63, hi = lane >> 5; const int wid = __builtin_amdgcn_readfirstlane(tid >> 6);
    const size_t rowbase = (size_t)MP + (size_t)b * DEC_SEQ;
    const int tq = PAST + (lane & 15);
    bf16x8 qr[4];
    { const bf16* qp = QB + (rowbase + (lane & 15)) * AW + h * HD + hi * 8;
#pragma unroll
      for (int d0 = 0; d0 < 4; ++d0) qr[d0] = *(const bf16x8*)(qp + d0 * 16); }
    f32x16 o[2]; o[0] = f32x16{}; o[1] = f32x16{};
    float carry = 0.f;
    LAS unsigned char* Kt = lds + wid * 16384; LAS unsigned char* Vt = Kt + 8192;
    const int tlo = 2 * wid, thi = (wid == 7) ? 17 : 2 * wid + 2;
    const int rr = lane >> 4, pc = lane & 15;
    for (int t = thi - 1; t >= tlo; --t) {
        if (t < 16) {
            const float* kb_ = ck + (((size_t)b * PAST + (size_t)t * 64) * NH + h) * HD + pc * 4;
            const float* vb_ = cv + (((size_t)b * PAST + (size_t)t * 64) * NH + h) * HD + pc * 4;
            f32x4 kv[16];
#pragma unroll
            for (int it = 0; it < 16; ++it) kv[it] = *(const f32x4*)(kb_ + (size_t)(4 * it + rr) * NH * HD);
#pragma unroll
            for (int it = 0; it < 16; ++it) {
                const int row = 4 * it + rr;
                v2u kw; kw.x = pk2(kv[it][0], kv[it][1]); kw.y = pk2(kv[it][2], kv[it][3]);
                *(LAS v2u*)(Kt + (pc >> 1) * 1024 + ((row + 2 * (pc >> 1)) & 63) * 16 + (pc & 1) * 8) = kw;
            }
#pragma unroll
            for (int it = 0; it < 16; ++it) kv[it] = *(const f32x4*)(vb_ + (size_t)(4 * it + rr) * NH * HD);
#pragma unroll
            for (int it = 0; it < 16; ++it) {
                const int row = 4 * it + rr;
                v2u vw; vw.x = pk2(kv[it][0], kv[it][1]); vw.y = pk2(kv[it][2], kv[it][3]);
                *(LAS v2u*)(Vt + (pc >> 3) * 4096 + row * 64 + (pc & 7) * 8) = vw;
            }
        } else {
#pragma unroll 4
            for (int it = 0; it < 16; ++it) {
                const int row = 4 * it + rr;
                v2u kw = {0u, 0u}, vw = {0u, 0u};
                if (row < DEC_SEQ) { kw = *(const v2u*)(KB + (rowbase + row) * AW + h * HD + pc * 4); vw = *(const v2u*)(VB + (rowbase + row) * AW + h * HD + pc * 4); }
                *(LAS v2u*)(Kt + (pc >> 1) * 1024 + ((row + 2 * (pc >> 1)) & 63) * 16 + (pc & 1) * 8) = kw;
                *(LAS v2u*)(Vt + (pc >> 3) * 4096 + row * 64 + (pc & 7) * 8) = vw;
            }
        }
        LDS_WAIT();
        if (t < 16) tile<false>(Kt, Vt, qr, o, carry, 64 * t, tq, lane);
        else tile<true>(Kt, Vt, qr, o, carry, 64 * t, tq, lane);
        LDS_WAIT();
    }
    LAS float* Ow = (LAS float*)(lds + wid * 16384);
#pragma unroll
    for (int d0 = 0; d0 < 2; ++d0)
#pragma unroll
        for (int r = 0; r < 8; ++r) Ow[crow(r, hi) * 64 + d0 * 32 + (lane & 31)] = o[d0][r];
    if (lane < 16) Ow[1024 + lane] = carry;
    __syncthreads();
    {
        const int q = tid >> 5, dp = (tid & 31) * 2;
        float a0 = 0.f, a1 = 0.f, sc = 1.f;
#pragma unroll
        for (int w = 7; w >= 0; --w) {
            const LAS float* O = (const LAS float*)(lds + w * 16384);
            a0 += sc * O[q * 64 + dp]; a1 += sc * O[q * 64 + dp + 1];
            sc *= __builtin_amdgcn_exp2f(-O[1024 + q]);
        }
        *(unsigned*)(ATT + (rowbase + q) * AW + h * HD + dp) = pk2(a0, a1);
    }
    __syncthreads();
}
}

template <int W>
__device__ __forceinline__ void pool_chunk(int ch, int c, const float* UB, const float* state_pool, bf16* POOLED, float* out) {
    const int r0 = ch * 16; const bool prompt = r0 < MP;
    const int t0 = prompt ? (r0 & (SEQ - 1)) : 0;
    const int bs = prompt ? 0 : ((r0 - MP) >> 4);
    f32x4 v[16 + W - 1];
#pragma unroll
    for (int k = 0; k < W - 1; ++k) {
        const int back = W - 1 - k;
        f32x4 x = {0.f, 0.f, 0.f, 0.f};
        if (prompt) { if (t0 - back >= 0) x = *(const f32x4*)(UB + (size_t)(r0 - back) * PW + c); }
        else x = *(const f32x4*)(state_pool + ((size_t)bs * PSTATE + (PSTATE - back)) * PW + c);
        v[k] = x;
    }
#pragma unroll
    for (int i = 0; i < 16; ++i) v[W - 1 + i] = *(const f32x4*)(UB + (size_t)(r0 + i) * PW + c);
#pragma unroll
    for (int i = 0; i < 16; ++i) {
        f32x4 s = v[i];
#pragma unroll
        for (int j = 1; j < W; ++j) s += v[i + j];
        const int t = t0 + i;
        const float inv = 1.0f / (float)(prompt ? min(t + 1, W) : W);
        const f32x4 own = v[W - 1 + i];
        const f32x4 pv = s * inv - own;
        v2u o; o.x = pk2(pv[0], pv[1]); o.y = pk2(pv[2], pv[3]);
        *(v2u*)(POOLED + (size_t)(r0 + i) * PW + c) = o;
        if (prompt) { if (t >= SEQ - PSTATE) *(f32x4*)(out + O_PP + ((size_t)(r0 >> 11) * PSTATE + (t - (SEQ - PSTATE))) * PW + c) = own; }
        else { if (i >= 1) *(f32x4*)(out + O_PS + ((size_t)bs * PSTATE + (i - 1)) * PW + c) = own; }
    }
}

namespace sg {
typedef float f32x4_ __attribute__((ext_vector_type(4)));
__device__ __forceinline__ void slice_mma(const bf16* A, int lda, const bf16* Bt, int K, int m0, int n0, int wave, int lane, f32x4 (&acc)[4][2]) {
    const int r = lane & 15, kg = lane >> 4, KS = K >> 3, steps = KS >> 5;
    const bf16* ap = A + (size_t)(m0 + r) * lda + wave * KS + kg * 8;
    const bf16* bp = Bt + (size_t)(n0 + r) * K + wave * KS + kg * 8;
    int s = 0;
    for (; s + 1 < steps; s += 2) {
        bf16x8 a[2][4], b[2][2];
#pragma unroll
        for (int h = 0; h < 2; ++h) {
#pragma unroll
            for (int i = 0; i < 4; ++i) a[h][i] = *(const bf16x8*)(ap + (size_t)(16 * i) * lda + (s + h) * 32);
#pragma unroll
            for (int j = 0; j < 2; ++j) b[h][j] = *(const bf16x8*)(bp + (size_t)(16 * j) * K + (s + h) * 32);
        }
#pragma unroll
        for (int h = 0; h < 2; ++h)
#pragma unroll
            for (int i = 0; i < 4; ++i)
#pragma unroll
                for (int j = 0; j < 2; ++j) acc[i][j] = __builtin_amdgcn_mfma_f32_16x16x32_bf16(b[h][j], a[h][i], acc[i][j], 0, 0, 0);
    }
    if (s < steps) {
        bf16x8 a[4], b[2];
#pragma unroll
        for (int i = 0; i < 4; ++i) a[i] = *(const bf16x8*)(ap + (size_t)(16 * i) * lda + s * 32);
#pragma unroll
        for (int j = 0; j < 2; ++j) b[j] = *(const bf16x8*)(bp + (size_t)(16 * j) * K + s * 32);
#pragma unroll
        for (int i = 0; i < 4; ++i)
#pragma unroll
            for (int j = 0; j < 2; ++j) acc[i][j] = __builtin_amdgcn_mfma_f32_16x16x32_bf16(b[j], a[i], acc[i][j], 0, 0, 0);
    }
}
__device__ __forceinline__ f32x4 reduce_tile(LAS unsigned char* lds, const f32x4 (&acc)[4][2], int wave, int lane, int tid) {
    LAS float* P = (LAS float*)lds + wave * 2048;
    const int r = lane & 15, fq = lane >> 4;
#pragma unroll
    for (int i = 0; i < 4; ++i)
#pragma unroll
        for (int j = 0; j < 2; ++j) *(LAS f32x4*)(P + (16 * i + r) * 32 + 16 * j + 4 * fq) = acc[i][j];
    __syncthreads();
    const LAS float* Q = (const LAS float*)lds + (tid >> 3) * 32 + (tid & 7) * 4;
    f32x4 v = *(const LAS f32x4*)Q;
#pragma unroll
    for (int w = 1; w < 8; ++w) v += *(const LAS f32x4*)(Q + w * 2048);
    __syncthreads();
    return v;
}
template <class Epi>
__device__ __forceinline__ void phase(LAS unsigned char* lds, const bf16* A, int lda, const bf16* Bt, int K, int N, int vcu, int G, const Epi& E) {
    int tid = threadIdx.x; asm volatile("" : "+v"(tid)); const int lane = tid & 63; const int wave = __builtin_amdgcn_readfirstlane(tid >> 6);
    const int nunits = 8 * (N / 32);
    for (int u = vcu; u < nunits; u += G) {
        const int mt = u & 7, nt = u >> 3;
        f32x4 acc[4][2];
#pragma unroll
        for (int i = 0; i < 4; ++i)
#pragma unroll
            for (int j = 0; j < 2; ++j) acc[i][j] = (f32x4){0.f, 0.f, 0.f, 0.f};
        slice_mma(A, lda, Bt, K, MP + 64 * mt, 32 * nt, wave, lane, acc);
        const f32x4 v = reduce_tile(lds, acc, wave, lane, tid);
        E(MP + 64 * mt + (tid >> 3), 32 * nt + (tid & 7) * 4, nt, v);
    }
}
__device__ __forceinline__ void phase_merge(LAS unsigned char* lds, const bf16* ATT, const bf16* WA, const bf16* POOLED, const bf16* WPB, const bf16* SG, bf16* MERGED, int vcu, int G) {
    int tid = threadIdx.x; asm volatile("" : "+v"(tid)); const int lane = tid & 63; const int wave = __builtin_amdgcn_readfirstlane(tid >> 6);
    for (int u = vcu; u < 8 * (D_MODEL / 32); u += G) {
        const int mt = u & 7, nt = u >> 3;
        f32x4 acc[4][2];
#pragma unroll
        for (int i = 0; i < 4; ++i)
#pragma unroll
            for (int j = 0; j < 2; ++j) acc[i][j] = (f32x4){0.f, 0.f, 0.f, 0.f};
        slice_mma(ATT, AW, WA, AW, MP + 64 * mt, 32 * nt, wave, lane, acc);
        const f32x4 va = reduce_tile(lds, acc, wave, lane, tid);
#pragma unroll
        for (int i = 0; i < 4; ++i)
#pragma unroll
            for (int j = 0; j < 2; ++j) acc[i][j] = (f32x4){0.f, 0.f, 0.f, 0.f};
        slice_mma(POOLED, PW, WPB, PW, MP + 64 * mt, 32 * nt, wave, lane, acc);
        const f32x4 vb = reduce_tile(lds, acc, wave, lane, tid);
        const int row = MP + 64 * mt + (tid >> 3), col = 32 * nt + (tid & 7) * 4;
        const v2u ga = *(const v2u*)(SG + (size_t)row * 2048 + col), gb = *(const v2u*)(SG + (size_t)row * 2048 + 1024 + col);
        const float m0 = bflo(ga.x) * va[0] + bflo(gb.x) * vb[0], m1 = bfhi(ga.x) * va[1] + bfhi(gb.x) * vb[1];
        const float m2 = bflo(ga.y) * va[2] + bflo(gb.y) * vb[2], m3 = bfhi(ga.y) * va[3] + bfhi(gb.y) * vb[3];
        v2u o; o.x = pk2(m0, m1); o.y = pk2(m2, m3);
        *(v2u*)(MERGED + (size_t)row * D_MODEL + col) = o;
    }
}
struct EpiInS {
    const float* rstd; bf16* QB; bf16* KB; bf16* VB; float* UB; bf16* SGp; float* out;
    __device__ __forceinline__ void operator()(int row, int col, int nt, f32x4 v) const {
        const float rs = rstd[row];
        v = v * rs;
        if (col < 512) { v = v * C2; v2u o; o.x = pk2(v[0], v[1]); o.y = pk2(v[2], v[3]); *(v2u*)(QB + (size_t)row * AW + col) = o; }
        else if (col < 1536) {
            const bool isk = col < 1024; const int c = col - (isk ? 512 : 1024);
            v2u o; o.x = pk2(v[0], v[1]); o.y = pk2(v[2], v[3]);
            *(v2u*)((isk ? KB : VB) + (size_t)row * AW + c) = o;
            *(f32x4*)(out + (isk ? O_KS : O_VS) + (size_t)(row - MP) * AW + c) = v;
        }
        else if (col < 2048) { *(f32x4*)(UB + (size_t)row * PW + (col - 1536)) = v; }
        else { v2u o; o.x = pk2(pg8::sigmoid_fast(v[0]), pg8::sigmoid_fast(v[1])); o.y = pk2(pg8::sigmoid_fast(v[2]), pg8::sigmoid_fast(v[3])); *(v2u*)(SGp + (size_t)row * 2048 + (col - 2048)) = o; }
    }
};
struct EpiRes1S {
    const float* xs; float* X1; bf16* X1B; float* SSQS;
    __device__ __forceinline__ void operator()(int row, int col, int nt, f32x4 v) const {
        const f32x4 x = *(const f32x4*)(xs + (size_t)(row - MP) * D_MODEL + col);
        v += x;
        *(f32x4*)(X1 + (size_t)row * D_MODEL + col) = v;
        v2u o; o.x = pk2(v[0], v[1]); o.y = pk2(v[2], v[3]); *(v2u*)(X1B + (size_t)row * D_MODEL + col) = o;
        float s = (v[0] * v[0] + v[1] * v[1]) + (v[2] * v[2] + v[3] * v[3]);
        s += __shfl_xor(s, 1); s += __shfl_xor(s, 2); s += __shfl_xor(s, 4);
        if ((threadIdx.x & 7) == 0) SSQS[(size_t)(row - MP) * 32 + nt] = s;
    }
};
struct EpiUpS {
    const float* SSQS; bf16* UP; float* out;
    __device__ __forceinline__ void operator()(int row, int col, int nt, f32x4 v) const {
        const f32x4* sp = (const f32x4*)(SSQS + (size_t)(row - MP) * 32);
        f32x4 t = sp[0];
#pragma unroll
        for (int k = 1; k < 8; ++k) t += sp[k];
        const float rs = __builtin_amdgcn_rsqf(((t[0] + t[1]) + (t[2] + t[3])) * (1.0f / D_MODEL) + EPS);
        v = v * rs;
        v2u o; o.x = pk2(v[0], v[1]); o.y = pk2(v[2], v[3]); *(v2u*)(UP + (size_t)row * FF2 + col) = o;
        if ((row & 15) >= 14) *(f32x4*)(out + O_CS + ((size_t)((row - MP) >> 4) * 2 + ((row & 15) - 14)) * FF2 + col) = v;
    }
};
struct EpiRes2S {
    float* X;
    __device__ __forceinline__ void operator()(int row, int col, int nt, f32x4 v) const {
        float* p = X + (size_t)row * D_MODEL + col; const f32x4 x = *(const f32x4*)p; *(f32x4*)p = v + x;
    }
};
}

__global__ void __launch_bounds__(NWAVES * 64, 2) fwd_mega(Args args) {
    extern __shared__ __attribute__((aligned(16))) unsigned char lds_raw[];
    LAS unsigned char* lds = (LAS unsigned char*)lds_raw;
    volatile LAS unsigned* MISC = (volatile LAS unsigned*)(lds + MISC_OFF);
#define PH_TID() int tid = threadIdx.x; asm volatile("" : "+v"(tid)); const int lane = tid & 63; const int wave = __builtin_amdgcn_readfirstlane(tid >> 6); \
    const int gw = vcu * NWAVES + wave, NGW = G * NWAVES; const int gt = vcu * (NWAVES * 64) + tid, NGT = G * NWAVES * 64; (void)lane; (void)gw; (void)NGW; (void)gt; (void)NGT
    const int G = gridDim.x; const int bx = blockIdx.x; const int vcu = (G % 8 == 0) ? (bx % 8) * (G / 8) + bx / 8 : bx;
#define PH_ARGS() \
    const __attribute__((address_space(4))) Args* ap_ = (const __attribute__((address_space(4))) Args*)__builtin_amdgcn_kernarg_segment_ptr(); asm volatile("" : "+s"(ap_)); \
    unsigned char* const ws = ap_->ws; float* const out = ap_->out; (void)ws; (void)out
#define IN(k) (ap_->in[k])
#define WSP(T, off) ((T*)(ws + (off)))
    gu32* ctl;
    { PH_ARGS(); ctl = (gu32*)(ws + WS_CTL); }
    for (int u = threadIdx.x; u < (LDS_BYTES - LDSCTL_OFF) / 4; u += NWAVES * 64) ((LAS unsigned*)(lds + LDSCTL_OFF))[u] = 0u;
    __syncthreads();
    XcdBarrier bar = xcd_barrier_post((unsigned*)(ctl + CW_BAR), MISC + 8);
#define STAMP_AT(k) do { if (PROBE_MASK) { if (bx == 0 && threadIdx.x == 0) { const unsigned long long t_ = __builtin_amdgcn_s_memrealtime(); MISC[16 + 2 * (k)] = (unsigned)t_; MISC[17 + 2 * (k)] = (unsigned)(t_ >> 32); } } } while (0)
    STAMP_AT(0);

    {
        PH_ARGS(); PH_TID(); bf16* WIN = WSP(bf16, WS_WIN); bf16* WA = WSP(bf16, WS_WA); bf16* WPB = WSP(bf16, WS_WPB); bf16* WO = WSP(bf16, WS_WO); bf16* WUP = WSP(bf16, WS_WUP); bf16* WDN = WSP(bf16, WS_WDN); float* RSTD1 = WSP(float, WS_RSTD1); bf16* XB = WSP(bf16, RA_XB); const float* x_prompt = IN(0); const float* x_sample = IN(1); const float* norm_mix = IN(6); const float* w_in = IN(7); const float* w_a = IN(8); const float* w_b = IN(9); const float* pool_w = IN(10); const float* pool_scale = IN(11); const float* w_o = IN(12); const float* norm_ffn = IN(13); const float* w_up = IN(14); const float* w_down = IN(17);
        LAS float* scr = (LAS float*)(lds + wave * 16384);
        constexpr int I_IN = (D_MODEL / 64) * (INW / 32), I_A = (AW / 64) * (D_MODEL / 32), I_O = (D_MODEL / 64) * (D_MODEL / 32), I_UP = (D_MODEL / 64) * (FF2 / 32), I_DN = (DFF / 64) * (D_MODEL / 32);
        constexpr int NITEMS = I_IN + I_A + I_O + I_UP + I_DN;
        if (wave >= 4) {
        const int gw4 = vcu * 4 + (wave - 4), NGW4 = G * 4;
        for (int it = gw4; it < NITEMS; it += NGW4) {
            int r = it;
            if (r < I_IN) { p0_transpose_item(w_in, norm_mix, D_MODEL, INW, WIN, scr, r, lane); continue; } r -= I_IN;
            if (r < I_A) { p0_transpose_item(w_a, nullptr, AW, D_MODEL, WA, scr, r, lane); continue; } r -= I_A;
            if (r < I_O) { p0_transpose_item(w_o, nullptr, D_MODEL, D_MODEL, WO, scr, r, lane); continue; } r -= I_O;
            if (r < I_UP) { p0_transpose_item(w_up, norm_ffn, D_MODEL, FF2, WUP, scr, r, lane); continue; } r -= I_UP;
            p0_transpose_item(w_down, nullptr, DFF, D_MODEL, WDN, scr, r, lane);
        }
        for (int task = gw4; task < 4 * 32 * 16; task += NGW4) {
            const int g = task >> 9, c0 = ((task >> 4) & 31) * 4, n = (task & 15) * 64 + lane;
            const float* pw = pool_w + ((size_t)g * PG + c0) * PG; const float* ps = pool_scale + g * PG; const float* wb = w_b + (size_t)g * PG * D_MODEL + n;
            float s0 = 0.f, s1 = 0.f, s2 = 0.f, s3 = 0.f;
#pragma unroll 16
            for (int d = 0; d < PG; ++d) { const float wv = wb[(size_t)d * D_MODEL] * ps[d];
                s0 = fmaf(pw[d], wv, s0); s1 = fmaf(pw[PG + d], wv, s1); s2 = fmaf(pw[2 * PG + d], wv, s2); s3 = fmaf(pw[3 * PG + d], wv, s3); }
            v2u o; o.x = pk2(s0, s1); o.y = pk2(s2, s3);
            *(v2u*)(WPB + (size_t)n * PW + g * PG + c0) = o;
        }
        } else {
        const int gw4 = vcu * 4 + wave, NGW4 = G * 4;
        for (int m = gw4; m < M; m += 2 * NGW4) {
            const int m2 = m + NGW4; const bool has2 = m2 < M; const int mm2 = has2 ? m2 : m;
            const float* xr = (m < MP) ? x_prompt + (size_t)m * D_MODEL : x_sample + (size_t)(m - MP) * D_MODEL;
            const float* xr2 = (mm2 < MP) ? x_prompt + (size_t)mm2 * D_MODEL : x_sample + (size_t)(mm2 - MP) * D_MODEL;
            const GAS f32x4* xv = (const GAS f32x4*)xr + lane; const GAS f32x4* xv2 = (const GAS f32x4*)xr2 + lane;
            f32x4 v[4], u[4]; float s = 0.f, s2 = 0.f;
#pragma unroll
            for (int j = 0; j < 4; ++j) { v[j] = xv[64 * j]; u[j] = xv2[64 * j]; }
#pragma unroll
            for (int j = 0; j < 4; ++j) { s += (v[j].x * v[j].x + v[j].y * v[j].y) + (v[j].z * v[j].z + v[j].w * v[j].w); s2 += (u[j].x * u[j].x + u[j].y * u[j].y) + (u[j].z * u[j].z + u[j].w * u[j].w); }
#pragma unroll
            for (int o = 1; o < 64; o <<= 1) { s += __shfl_xor(s, o); s2 += __shfl_xor(s2, o); }
            if (lane == 0) { RSTD1[m] = 1.0f / sqrtf(s * (1.0f / D_MODEL) + EPS); if (has2) RSTD1[m2] = 1.0f / sqrtf(s2 * (1.0f / D_MODEL) + EPS); }
            GAS v2u* o8 = (GAS v2u*)(XB + (size_t)m * D_MODEL) + lane;
#pragma unroll
            for (int j = 0; j < 4; ++j) { v2u w; w.x = pk2(v[j].x, v[j].y); w.y = pk2(v[j].z, v[j].w); o8[64 * j] = w; }
            if (has2) { GAS v2u* o82 = (GAS v2u*)(XB + (size_t)m2 * D_MODEL) + lane;
#pragma unroll
                for (int j = 0; j < 4; ++j) { v2u w; w.x = pk2(u[j].x, u[j].y); w.y = pk2(u[j].z, u[j].w); o82[64 * j] = w; } }
        }
        }
    }
    xcd_barrier(bar); STAMP_AT(1);

    {
        PH_ARGS(); PH_TID(); bf16* XB = WSP(bf16, RA_XB); bf16* WIN = WSP(bf16, WS_WIN); float* RSTD1 = WSP(float, WS_RSTD1); bf16* QB = WSP(bf16, RA_QB); bf16* KB = WSP(bf16, RA_KB); bf16* VB = WSP(bf16, RA_VB); float* UB = WSP(float, RA_UB); bf16* SG = WSP(bf16, RA_SG);
        pg8::Gemm g{XB, WIN, MP, INW, D_MODEL, D_MODEL}; pg8::StaticOrder S; S.init(MP, INW, G, bx);
        pg8::EpiIn E{RSTD1, QB, KB, VB, UB, SG, out};
        pg8::gemm_phase<pg8::EpiIn, pg8::StaticOrder, true>(lds, g, S, E);
        sg::EpiInS ES{RSTD1, QB, KB, VB, UB, SG, out};
        sg::phase(lds, XB, D_MODEL, WIN, D_MODEL, INW, vcu, G, ES);
    }
    xcd_barrier(bar); STAMP_AT(2);

    {
        PH_ARGS(); PH_TID(); bf16* QB = WSP(bf16, RA_QB); bf16* KB = WSP(bf16, RA_KB); bf16* VB = WSP(bf16, RA_VB); bf16* ATT = WSP(bf16, RA_QB); float* UB = WSP(float, RA_UB); bf16* POOLED = WSP(bf16, RA_XB); const float* cache_k = IN(2); const float* cache_v = IN(3); const float* state_pool = IN(4);
        for (int u = gw; u < 64 * BATCH * NH; u += NGW) {
            const int jq = u >> 7, bh = u & 127;
            sb::wave_unit_prompt(lds + wave * 16384, bh >> 3, bh & 7, jq, QB, KB, VB, ATT, lane);
        }
        __syncthreads();
        STAMP_AT(3);
        for (int u = vcu; u < DEC_BATCH * NH; u += G) sb::unit_sample(lds, u >> 3, u & 7, QB, KB, VB, cache_k, cache_v, ATT);
        STAMP_AT(4);
        for (int task = gt; task < (M / 16) * (PW / 4); task += NGT) {
            const int ch = task >> 7, c = (task & 127) * 4;
            switch (c >> 7) {
                case 0: pool_chunk<2>(ch, c, UB, state_pool, POOLED, out); break;
                case 1: pool_chunk<4>(ch, c, UB, state_pool, POOLED, out); break;
                case 2: pool_chunk<8>(ch, c, UB, state_pool, POOLED, out); break;
                default: pool_chunk<16>(ch, c, UB, state_pool, POOLED, out); break;
            }
        }
    }
    xcd_barrier(bar); STAMP_AT(5);

    {
        PH_ARGS(); PH_TID(); bf16* ATT = WSP(bf16, RA_QB); bf16* WA = WSP(bf16, WS_WA); bf16* MERGED = WSP(bf16, RA_KB); bf16* SG = WSP(bf16, RA_SG);
        pg8::Gemm g{ATT, WA, MP, D_MODEL, AW, AW}; pg8::StaticOrder S; S.init(MP, D_MODEL, G, bx);
        pg8::EpiGate<false> E{MERGED, SG, 0};
        pg8::gemm_phase<pg8::EpiGate<false>, pg8::StaticOrder, true>(lds, g, S, E);
    }
    {
        PH_ARGS(); PH_TID(); bf16* ATT = WSP(bf16, RA_QB); bf16* WA = WSP(bf16, WS_WA); bf16* POOLED = WSP(bf16, RA_XB); bf16* WPB = WSP(bf16, WS_WPB); bf16* MERGED = WSP(bf16, RA_KB); bf16* SG = WSP(bf16, RA_SG);
        pg8::Gemm g{POOLED, WPB, MP, D_MODEL, PW, PW}; pg8::StaticOrder S; S.init(MP, D_MODEL, G, bx);
        pg8::EpiGate<true> E{MERGED, SG, 1024};
        pg8::gemm_phase<pg8::EpiGate<true>, pg8::StaticOrder, true>(lds, g, S, E);
        sg::phase_merge(lds, ATT, WA, POOLED, WPB, SG, MERGED, vcu, G);
    }
    xcd_barrier(bar); STAMP_AT(6);

    {
        PH_ARGS(); PH_TID(); bf16* MERGED = WSP(bf16, RA_KB); bf16* WO = WSP(bf16, WS_WO); const float* x_prompt = IN(0); const float* x_sample = IN(1); float* X1 = out + O_YP; bf16* X1B = WSP(bf16, WS_X1B); float* SSQ = WSP(float, WS_SSQ); float* SSQS = WSP(float, WS_SSQS);
        pg8::Gemm g{MERGED, WO, MP, D_MODEL, D_MODEL, D_MODEL}; pg8::StaticOrder S; S.init(MP, D_MODEL, G, bx);
        pg8::EpiRes1 E{x_prompt, x_sample, X1, X1B, SSQ};
        pg8::gemm_phase<pg8::EpiRes1, pg8::StaticOrder, true>(lds, g, S, E);
        sg::EpiRes1S ES{x_sample, X1, X1B, SSQS};
        sg::phase(lds, MERGED, D_MODEL, WO, D_MODEL, D_MODEL, vcu, G, ES);
    }
    xcd_barrier(bar); STAMP_AT(7);

    {
        PH_ARGS(); PH_TID(); bf16* X1B = WSP(bf16, WS_X1B); bf16* WUP = WSP(bf16, WS_WUP); float* SSQ = WSP(float, WS_SSQ); float* SSQS = WSP(float, WS_SSQS); bf16* UP = WSP(bf16, RA_UP); bf16* HALO = WSP(bf16, WS_HALO);
        pg8::Gemm g{X1B, WUP, MP, FF2, D_MODEL, D_MODEL}; pg8::StaticOrder S; S.init(MP, FF2, G, bx);
        pg8::EpiUp E{SSQ, UP, HALO, out};
        pg8::gemm_phase<pg8::EpiUp, pg8::StaticOrder, true>(lds, g, S, E);
        sg::EpiUpS ES{SSQS, UP, out};
        sg::phase(lds, X1B, D_MODEL, WUP, D_MODEL, FF2, vcu, G, ES);
    }
    xcd_barrier(bar); STAMP_AT(8);

    {
        PH_ARGS(); PH_TID(); bf16* UP = WSP(bf16, RA_UP); bf16* HALO = WSP(bf16, WS_HALO); const float* state_conv = IN(5); const float* conv_w = IN(15); const float* conv_b = IN(16);
        constexpr int NSEG = M / 32, NCG = DFF / 8;
        for (int task = gt; task < NSEG * NCG; task += NGT) {
            const int seg = task / NCG, c = (task % NCG) * 8; const int r0 = seg * 32;
            const bool prompt = r0 < MP;
            float w0[16], w1[16], w2[16], cb[16], p2[16], p1[16];
#pragma unroll
            for (int hh = 0; hh < 2; ++hh)
#pragma unroll
                for (int e = 0; e < 8; e += 4) {
                    const int cc = c + hh * DFF + e;
                    const f32x4 a = *(const f32x4*)(conv_w + cc), b_ = *(const f32x4*)(conv_w + FF2 + cc), d = *(const f32x4*)(conv_w + 2 * FF2 + cc), bb = *(const f32x4*)(conv_b + cc);
#pragma unroll
                    for (int k = 0; k < 4; ++k) { w0[hh * 8 + e + k] = a[k]; w1[hh * 8 + e + k] = b_[k]; w2[hh * 8 + e + k] = d[k]; cb[hh * 8 + e + k] = bb[k]; }
                }
            if (prompt) {
                if ((r0 & (SEQ - 1)) == 0) {
#pragma unroll
                    for (int k = 0; k < 16; ++k) { p2[k] = 0.f; p1[k] = 0.f; }
                } else {
#pragma unroll
                    for (int hh = 0; hh < 2; ++hh) {
                        const v4u a = *(const v4u*)(HALO + ((size_t)(seg - 1) * 2 + 0) * FF2 + c + hh * DFF), b_ = *(const v4u*)(HALO + ((size_t)(seg - 1) * 2 + 1) * FF2 + c + hh * DFF);
                        p2[hh * 8 + 0] = bflo(a.x); p2[hh * 8 + 1] = bfhi(a.x); p2[hh * 8 + 2] = bflo(a.y); p2[hh * 8 + 3] = bfhi(a.y);
                        p2[hh * 8 + 4] = bflo(a.z); p2[hh * 8 + 5] = bfhi(a.z); p2[hh * 8 + 6] = bflo(a.w); p2[hh * 8 + 7] = bfhi(a.w);
                        p1[hh * 8 + 0] = bflo(b_.x); p1[hh * 8 + 1] = bfhi(b_.x); p1[hh * 8 + 2] = bflo(b_.y); p1[hh * 8 + 3] = bfhi(b_.y);
                        p1[hh * 8 + 4] = bflo(b_.z); p1[hh * 8 + 5] = bfhi(b_.z); p1[hh * 8 + 6] = bflo(b_.w); p1[hh * 8 + 7] = bfhi(b_.w);
                    }
                }
            }
#pragma unroll 2
            for (int i = 0; i < 32; ++i) {
                const int r = r0 + i;
                if (!prompt && (i & 15) == 0) {
                    const float* sc = state_conv + (size_t)((r - MP) >> 4) * 2 * FF2;
#pragma unroll
                    for (int hh = 0; hh < 2; ++hh)
#pragma unroll
                        for (int e = 0; e < 8; e += 4) {
                            const f32x4 a = *(const f32x4*)(sc + c + hh * DFF + e), b_ = *(const f32x4*)(sc + FF2 + c + hh * DFF + e);
#pragma unroll
                            for (int k = 0; k < 4; ++k) { p2[hh * 8 + e + k] = a[k]; p1[hh * 8 + e + k] = b_[k]; }
                        }
                }
                bf16* rowp = UP + (size_t)r * FF2 + c;
                const v4u gv = *(const v4u*)rowp, vv = *(const v4u*)(rowp + DFF);
                float cur[16];
                cur[0] = bflo(gv.x); cur[1] = bfhi(gv.x); cur[2] = bflo(gv.y); cur[3] = bfhi(gv.y); cur[4] = bflo(gv.z); cur[5] = bfhi(gv.z); cur[6] = bflo(gv.w); cur[7] = bfhi(gv.w);
                cur[8] = bflo(vv.x); cur[9] = bfhi(vv.x); cur[10] = bflo(vv.y); cur[11] = bfhi(vv.y); cur[12] = bflo(vv.z); cur[13] = bfhi(vv.z); cur[14] = bflo(vv.w); cur[15] = bfhi(vv.w);
                float act[8];
#pragma unroll
                for (int k = 0; k < 8; ++k) {
                    const float gt_ = cb[k] + w0[k] * p2[k] + w1[k] * p1[k] + w2[k] * cur[k];
                    const float vl = cb[8 + k] + w0[8 + k] * p2[8 + k] + w1[8 + k] * p1[8 + k] + w2[8 + k] * cur[8 + k];
                    const float inner = gt_ * (1.0f + 0.044715f * gt_ * gt_);
                    const float sg = __builtin_amdgcn_rcpf(1.0f + __builtin_amdgcn_exp2f(-2.0f * 0.7978845608028654f * 1.4426950408889634f * inner));
                    act[k] = gt_ * sg * vl;
                }
#pragma unroll
                for (int k = 0; k < 16; ++k) { p2[k] = p1[k]; p1[k] = cur[k]; }
                v4u o; o.x = pk2(act[0], act[1]); o.y = pk2(act[2], act[3]); o.z = pk2(act[4], act[5]); o.w = pk2(act[6], act[7]);
                *(v4u*)rowp = o;
            }
        }
    }
    xcd_barrier(bar); STAMP_AT(9);

    {
        PH_ARGS(); PH_TID(); bf16* UP = WSP(bf16, RA_UP); bf16* WDN = WSP(bf16, WS_WDN); float* X1 = out + O_YP;
        pg8::Gemm g{UP, WDN, MP, D_MODEL, DFF, FF2}; pg8::StaticOrder S; S.init(MP, D_MODEL, G, bx);
        pg8::EpiRes2 E{X1};
        pg8::gemm_phase<pg8::EpiRes2, pg8::StaticOrder, true>(lds, g, S, E);
        sg::EpiRes2S ES{X1};
        sg::phase(lds, UP, FF2, WDN, DFF, D_MODEL, vcu, G, ES);
    }
    xcd_barrier(bar); STAMP_AT(10);

    {
        PH_ARGS(); PH_TID(); float* X1 = out + O_YP; const float* norm_final = IN(18);
    for (int m = gw; m < M; m += NGW) {
        GAS f32x4* xv = (GAS f32x4*)(X1 + (size_t)m * D_MODEL) + lane;
        f32x4 v[4]; float s = 0.f;
#pragma unroll
        for (int j = 0; j < 4; ++j) { v[j] = xv[64 * j]; s += (v[j].x * v[j].x + v[j].y * v[j].y) + (v[j].z * v[j].z + v[j].w * v[j].w); }
#pragma unroll
        for (int o = 1; o < 64; o <<= 1) s += __shfl_xor(s, o);
        const float rs = 1.0f / sqrtf(s * (1.0f / D_MODEL) + EPS);
#pragma unroll
        for (int j = 0; j < 4; ++j) { const f32x4 gv = *((const f32x4*)norm_final + lane + 64 * j); xv[64 * j] = v[j] * rs * gv; }
    }
    }
    if (PROBE_MASK) { STAMP_AT(11); if (bx == 0 && threadIdx.x == 0) { unsigned long long acc_ = 0ull;
        for (int k = 0; k < 11; ++k) if ((PROBE_MASK >> k) & 1) { const unsigned long long a_ = ((unsigned long long)MISC[17 + 2 * k] << 32) | MISC[16 + 2 * k], b_ = ((unsigned long long)MISC[19 + 2 * k] << 32) | MISC[18 + 2 * k]; acc_ += b_ - a_; }
        const unsigned long long t0_ = __builtin_amdgcn_s_memrealtime(); while (__builtin_amdgcn_s_memrealtime() - t0_ < acc_ * PROBE_MULT) __builtin_amdgcn_s_sleep(8); } }
}

extern "C" void kernel_launch(void* const* d_in, const int* in_sizes, int n_in, void* d_out, int out_size, void* d_ws, size_t ws_size, hipStream_t stream) {
    static int grid = 0;
    if (grid == 0) {
        if (n_in != 19 || (size_t)out_size != O_END || ws_size < WS_END) {
            fprintf(stderr, "kernel_launch: unexpected sizes n_in %d out %d ws %zu (need %zu)\n", n_in, out_size, ws_size, (size_t)WS_END); grid = -1; return; }
        int dev = 0, cus = 0, per_cu = 0;
        if (hipGetDevice(&dev) != hipSuccess || hipDeviceGetAttribute(&cus, hipDeviceAttributeMultiprocessorCount, dev) != hipSuccess) { grid = -1; return; }
        if (hipFuncSetAttribute((const void*)fwd_mega, hipFuncAttributeMaxDynamicSharedMemorySize, LDS_BYTES) != hipSuccess) { fprintf(stderr, "kernel_launch: hipFuncSetAttribute failed\n"); grid = -1; return; }
        if (hipOccupancyMaxActiveBlocksPerMultiprocessor(&per_cu, (const void*)fwd_mega, NWAVES * 64, LDS_BYTES) != hipSuccess || per_cu < 1)
            fprintf(stderr, "kernel_launch: occupancy query reports %d blocks per CU\n", per_cu);
        (void)hipGetLastError();
        grid = cus;
    }
    if (grid < 0) return;
    (void)hipMemsetAsync((char*)d_ws + WS_CTL, 0, CTL_ZERO_BYTES, stream);
    Args a{};
    for (int i = 0; i < 19; ++i) a.in[i] = (const float*)d_in[i];
    a.out = (float*)d_out; a.ws = (unsigned char*)d_ws;
    hipLaunchKernelGGL(fwd_mega, dim3(grid), dim3(NWAVES * 64), LDS_BYTES, stream, a);
}
```
